# Optimizing an MI355X kernel written in HIP

```python
import jax, jax.numpy as jnp
from jax import lax
import numpy as np

D_MODEL = 1024
BATCH = 8
SEQ = 4096
DEPTH = 1

CHUNK = 64
POOL_WINDOWS = (2, 4, 8, 16)
N_POOL_GROUPS = len(POOL_WINDOWS)
D_POOL = D_MODEL
POOL_GROUP = D_POOL // N_POOL_GROUPS
SGU_BLOCK = 128
N_SGU_HEADS = 4
D_SGU = D_MODEL
SGU_HEAD = D_SGU // N_SGU_HEADS
D_IN = D_POOL + 2 * D_SGU + D_POOL + D_SGU
D_FF = 4 * D_MODEL
EPS = 1e-6

kernel_name = "hybrid_pool_sgu_gated_block"


def rms_norm(x, g):
    xf = x.astype(jnp.float32)
    y = xf * lax.rsqrt(jnp.mean(xf * xf, axis=-1, keepdims=True) + EPS)
    return (y * g.astype(jnp.float32)).astype(x.dtype)


def layer_norm(x, g, b):
    xf = x.astype(jnp.float32)
    mu = jnp.mean(xf, axis=-1, keepdims=True)
    xc = xf - mu
    y = xc * lax.rsqrt(jnp.mean(xc * xc, axis=-1, keepdims=True) + EPS)
    return (y * g.astype(jnp.float32) + b.astype(jnp.float32)).astype(x.dtype)


def multiscale_pool(p):
    s_len = p.shape[1]
    pf = p.astype(jnp.float32)
    csum = jnp.cumsum(pf, axis=1)
    pos1 = jnp.arange(1, s_len + 1)
    outs = []
    for gi, w in enumerate(POOL_WINDOWS):
        sl = slice(gi * POOL_GROUP, (gi + 1) * POOL_GROUP)
        cg = csum[..., sl]
        prev = jnp.pad(cg, ((0, 0), (w, 0), (0, 0)))[:, :s_len]
        cnt = jnp.minimum(pos1, w).astype(jnp.float32)[None, :, None]
        outs.append((cg - prev) / cnt - pf[..., sl])
    return jnp.stack(outs, axis=2).astype(p.dtype)


def chunk_causal_block_mask():
    pos = jnp.arange(SGU_BLOCK)
    return (pos[:, None] // CHUNK) >= (pos[None, :] // CHUNK)


def setup_inputs(seed: int = 0) -> dict:
    key = jax.random.key(seed)
    ks = jax.random.split(key, 20)
    f32 = jnp.float32
    nrm = lambda k, shape, s: jax.random.normal(k, shape, f32) * s
    return {
        "x": jax.random.normal(ks[0], (BATCH, SEQ, D_MODEL), f32),
        "norm1_pre_g": 1.0 + nrm(ks[1], (D_MODEL,), 0.05),
        "w_in": nrm(ks[2], (D_MODEL, D_IN), D_MODEL ** -0.5),
        "b_in": nrm(ks[3], (D_IN,), 0.02),
        "w_pool": nrm(ks[4], (N_POOL_GROUPS, POOL_GROUP, POOL_GROUP), POOL_GROUP ** -0.5),
        "pool_scale": 1.0 + nrm(ks[5], (D_POOL,), 0.1),
        "sgu_ln_g": 1.0 + nrm(ks[6], (D_SGU,), 0.05),
        "sgu_ln_b": nrm(ks[7], (D_SGU,), 0.02),
        "w_spatial": nrm(ks[8], (N_SGU_HEADS, SGU_BLOCK, SGU_BLOCK), SGU_BLOCK ** -0.5),
        "b_spatial": 1.0 + nrm(ks[9], (N_SGU_HEADS, SGU_BLOCK), 0.02),
        "w_sgu_proj": nrm(ks[10], (N_SGU_HEADS, SGU_HEAD, SGU_HEAD), SGU_HEAD ** -0.5),
        "w_out": nrm(ks[11], (D_MODEL, D_MODEL), D_MODEL ** -0.5),
        "norm1_post_g": 1.0 + nrm(ks[12], (D_MODEL,), 0.05),
        "norm2_pre_g": 1.0 + nrm(ks[13], (D_MODEL,), 0.05),
        "w_ff1": nrm(ks[14], (D_MODEL, D_FF), D_MODEL ** -0.5),
        "w_ff2": nrm(ks[15], (D_FF, D_MODEL), D_FF ** -0.5),
        "norm2_post_g": 1.0 + nrm(ks[16], (D_MODEL,), 0.05),
    }


def reference(x, norm1_pre_g, w_in, b_in, w_pool, pool_scale, sgu_ln_g, sgu_ln_b,
              w_spatial, b_spatial, w_sgu_proj, w_out, norm1_post_g, norm2_pre_g,
              w_ff1, w_ff2, norm2_post_g):
    bsz, s_len, _ = x.shape
    n_blk = s_len // SGU_BLOCK
    h = x
    for _ in range(DEPTH):
        xn = rms_norm(h, norm1_pre_g)
        z = jnp.einsum('bsd,de->bse', xn, w_in) + b_in
        o = 0
        z_pool = z[..., o:o + D_POOL]; o += D_POOL
        z_u = z[..., o:o + D_SGU]; o += D_SGU
        z_v = z[..., o:o + D_SGU]; o += D_SGU
        z_ga = z[..., o:o + D_POOL]; o += D_POOL
        z_gb = z[..., o:o + D_SGU]

        pooled = multiscale_pool(z_pool)
        a = jnp.einsum('bsgc,gcd->bsgd', pooled, w_pool).reshape(bsz, s_len, D_POOL)
        a = a * pool_scale

        u = jax.nn.gelu(z_u)
        v = layer_norm(jax.nn.gelu(z_v), sgu_ln_g, sgu_ln_b)
        vb = v.reshape(bsz, n_blk, SGU_BLOCK, N_SGU_HEADS, SGU_HEAD)
        ws = jnp.where(chunk_causal_block_mask()[None], w_spatial, 0.0).astype(v.dtype)
        sv = jnp.einsum('hij,bnjhc->bnihc', ws, vb) + b_spatial.T[None, None, :, :, None]
        gated = u.reshape(bsz, n_blk, SGU_BLOCK, N_SGU_HEADS, SGU_HEAD) * sv
        bbr = jnp.einsum('bnihc,hcd->bnihd', gated, w_sgu_proj).reshape(bsz, s_len, D_SGU)

        merged = jax.nn.sigmoid(z_ga) * a + jax.nn.sigmoid(z_gb) * bbr
        y = jnp.einsum('bsd,de->bse', merged, w_out)
        h = h + rms_norm(y, norm1_post_g)

        hn = rms_norm(h, norm2_pre_g)
        f = jnp.square(jax.nn.relu(jnp.einsum('bsd,df->bsf', hn, w_ff1)))
        f = jnp.einsum('bsf,fd->bsd', f, w_ff2)
        h = h + rms_norm(f, norm2_post_g)
    return h
```

```cpp
#include <hip/hip_runtime.h>
#include <hip/hip_cooperative_groups.h>
#include <cstdio>
#include <cstdint>
namespace cg = cooperative_groups;

#define LAS __attribute__((address_space(3)))
typedef unsigned short bf16_t;
typedef short bf16x8 __attribute__((ext_vector_type(8)));
typedef short s16x4 __attribute__((ext_vector_type(4)));
typedef float f32x4 __attribute__((ext_vector_type(4)));
typedef float f32x2 __attribute__((ext_vector_type(2)));
typedef unsigned u32x4 __attribute__((ext_vector_type(4)));
typedef unsigned u32x2 __attribute__((ext_vector_type(2)));

constexpr int DM = 1024, NB = 8, SEQ = 4096, M = NB * SEQ;
constexpr int DIN = 5120, DFF = 4096;
constexpr int SBLK = 128;
constexpr float EPS = 1e-6f;
constexpr int NWAVES = 8;

constexpr size_t MiB = 1u << 20;
constexpr size_t WS_WIN = 0;
constexpr size_t WS_WOUT = 10 * MiB;
constexpr size_t WS_WFF1 = 12 * MiB;
constexpr size_t WS_WFF2 = 20 * MiB;
constexpr size_t WS_WPOOL = 28 * MiB;
constexpr size_t WS_WSGU = 28 * MiB + 512 * 1024;
constexpr size_t WS_WSP = 29 * MiB;
constexpr size_t WS_BAR = 30 * MiB;
constexpr size_t WS_R1 = 32 * MiB;
constexpr size_t WS_R2 = 96 * MiB;
constexpr size_t WS_Z = 160 * MiB;
constexpr size_t WS_Y = WS_Z + 256 * MiB;
constexpr size_t WS_PART = 480 * MiB;
constexpr size_t WS_END = 484 * MiB;

constexpr int LDS_BYTES = 147456;
constexpr int VS_STRIDE = 528;
constexpr int MX_VS = 0, MX_PS = 128 * VS_STRIDE, MX_ST = (128 + 143) * VS_STRIDE;

__device__ __forceinline__ unsigned f2bf(float f) { unsigned u = __builtin_bit_cast(unsigned, f); return (u + 0x7fffu + ((u >> 16) & 1u)) >> 16; }
typedef __bf16 bf16x2_t __attribute__((ext_vector_type(2)));
__device__ __forceinline__ unsigned pk2(float lo, float hi) { const f32x2 v = {lo, hi}; const bf16x2_t b = __builtin_convertvector(v, bf16x2_t); return __builtin_bit_cast(unsigned, b); }
__device__ __forceinline__ float bf_lo(unsigned u) { return __builtin_bit_cast(float, u << 16); }
__device__ __forceinline__ float bf_hi(unsigned u) { return __builtin_bit_cast(float, u & 0xffff0000u); }
__device__ __forceinline__ float gelu_tanh(float x) {
    const float t = x * (1.0f + 0.044715f * x * x);
    const float e = __builtin_amdgcn_exp2f(-2.3022081984f * t);
    return x * __builtin_amdgcn_rcpf(1.0f + e);
}
__device__ __forceinline__ f32x4 gelu_tanh4(f32x4 x) {
    const f32x4 t = x * (x * x * 0.044715f + 1.0f), z = t * (-2.3022081984f);
    f32x4 e; e.x = __builtin_amdgcn_exp2f(z.x); e.y = __builtin_amdgcn_exp2f(z.y); e.z = __builtin_amdgcn_exp2f(z.z); e.w = __builtin_amdgcn_exp2f(z.w);
    const f32x4 d = e + 1.0f;
    f32x4 r; r.x = __builtin_amdgcn_rcpf(d.x); r.y = __builtin_amdgcn_rcpf(d.y); r.z = __builtin_amdgcn_rcpf(d.z); r.w = __builtin_amdgcn_rcpf(d.w);
    return x * r;
}
__device__ __forceinline__ f32x4 sigmoid4(f32x4 x) {
    const f32x4 z = x * (-1.4426950409f);
    f32x4 e; e.x = __builtin_amdgcn_exp2f(z.x); e.y = __builtin_amdgcn_exp2f(z.y); e.z = __builtin_amdgcn_exp2f(z.z); e.w = __builtin_amdgcn_exp2f(z.w);
    const f32x4 d = e + 1.0f;
    f32x4 r; r.x = __builtin_amdgcn_rcpf(d.x); r.y = __builtin_amdgcn_rcpf(d.y); r.z = __builtin_amdgcn_rcpf(d.z); r.w = __builtin_amdgcn_rcpf(d.w);
    return r;
}
__device__ __forceinline__ float sigmoidf_(float x) { return __builtin_amdgcn_rcpf(1.0f + __builtin_amdgcn_exp2f(-1.4426950409f * x)); }
__device__ __forceinline__ float wave_sum(float v) {
#pragma unroll
    for (int o = 1; o < 64; o <<= 1) v += __shfl_xor(v, o);
    return v;
}

__host__ __device__ __forceinline__ size_t tm_off(int r, int c8, int K) {
    int ob = (r & 15) * 64 + (c8 & 31) * 2; ob ^= ((ob >> 9) & 1) << 5;
    return ((size_t)(r >> 4) * (K >> 5) + (c8 >> 5)) * 512 + (ob >> 1);
}
namespace pg8 {
constexpr int BM = 256, BK = 64, HALF = 128, HTB = HALF * BK * 2, STAGE_BYTES = 8 * HTB, NXCD = 8, WGM = 8;
__host__ __device__ __forceinline__ int lds_byte(int r, int c) { const int st = (r >> 4) * 2 + (c >> 5), rr = r & 15, cc = c & 31, ob = rr * 64 + cc * 2; return st * 1024 + (ob ^ (((ob >> 9) & 1) << 5)); }
__host__ __device__ __forceinline__ void stage_rc(int b, int& R, int& C) { const int st = b / 1024, sb = b % 1024, swz = sb ^ (((sb >> 9) & 1) << 5); R = (st >> 1) * 16 + swz / 64; C = (st & 1) * 32 + (swz % 64) / 2; }
__host__ __device__ __forceinline__ int perm32(int rho) { const int n = rho >> 4, i = rho & 15; return 8 * (i >> 2) + 4 * n + (i & 3); }

struct Unit { int pm, pn; };
struct Gemm { const bf16_t* A; const bf16_t* Bt; int M, N, K; };

struct StaticOrder {
    int nM, nN, nwg, G, c;
    __host__ __device__ void init(int M_, int N_, int G_, int c_) { nM = M_ / BM; nN = N_ / BM; nwg = nM * nN; G = G_; c = c_; }
    __host__ __device__ bool next(int i, Unit& u) const {
        const long L = (long)i * G + c; if (L >= nwg) return false;
        int wgid = (int)L; { const int q = nwg / NXCD, r = nwg % NXCD, xcd = wgid % NXCD, off = wgid / NXCD; wgid = (xcd < r ? xcd * (q + 1) : r * (q + 1) + (xcd - r) * q) + off; }
        const int nig = WGM * nN, gid = wgid / nig, fm = gid * WGM, gsz = (nM - fm) < WGM ? (nM - fm) : WGM;
        u.pm = fm + ((wgid % nig) % gsz); u.pn = (wgid % nig) / gsz; return true;
    }
    __device__ __forceinline__ void a_ready(const Unit&) const {}
    __device__ __forceinline__ void done(const Unit&) const {}
};

struct EpiF32 {
    static constexpr bool PERM = false, AFTER_DRAIN = false;
    float* C; int ldc;
    __device__ __forceinline__ void operator()(const f32x4 (&acc)[2][2][4][2], const Unit& u, int wr, int wc, int fr, int fq) const {
        const int row0 = u.pm * BM + wr * 64 + fr, col0 = u.pn * BM + wc * 32 + 4 * fq;
#pragma unroll
        for (int ai = 0; ai < 2; ++ai)
#pragma unroll
            for (int m = 0; m < 4; ++m) { float* rowp = C + (size_t)(row0 + ai * HALF + m * 16) * ldc + col0;
#pragma unroll
                for (int bj = 0; bj < 2; ++bj)
#pragma unroll
                    for (int n = 0; n < 2; ++n) *(f32x4*)(rowp + bj * HALF + n * 16) = acc[ai][bj][m][n]; }
    }
};
template <int MODE> struct EpiBf16 {
    static constexpr bool PERM = true, AFTER_DRAIN = false;
    bf16_t* O; int ldc; const float* bias; float* part;
    __device__ __forceinline__ void operator()(const f32x4 (&acc)[2][2][4][2], const Unit& u, int wr, int wc, int fr, int fq) const {
        const int row0 = u.pm * BM + wr * 64 + fr, col0 = u.pn * BM + wc * 32 + 8 * fq;
        const int seg = u.pn >> 2; const int act = (MODE == 0) ? ((seg == 1 || seg == 2) ? 1 : (seg >= 3 ? 2 : 0)) : (MODE == 1 ? 3 : 0);
        const bool tiled = (MODE == 0) && (seg == 1 || seg >= 3);
        const int lane = fq * 16 + fr;
        f32x4 bv[2][2];
#pragma unroll
        for (int bj = 0; bj < 2; ++bj)
#pragma unroll
            for (int n = 0; n < 2; ++n) bv[bj][n] = (MODE == 0) ? *(const f32x4*)(bias + col0 + bj * HALF + 4 * n) : (f32x4){0.f, 0.f, 0.f, 0.f};
#pragma unroll
        for (int ai = 0; ai < 2; ++ai)
#pragma unroll
            for (int m = 0; m < 4; ++m) {
                bf16_t* rowp;
                if (MODE == 0) {
                    bf16_t* plane = O + (size_t)seg * ((size_t)M * 1024);
                    const int cseg = (u.pn & 3) * BM + wc * 32;
                    const int rt = (u.pm * BM + wr * 64 + ai * HALF + m * 16) >> 4;
                    rowp = tiled ? plane + ((size_t)rt * 32 + (cseg >> 5)) * 512 + lane * 8
                                 : plane + (size_t)(row0 + ai * HALF + m * 16) * 1024 + cseg + 8 * fq;
                } else rowp = O + (size_t)(row0 + ai * HALF + m * 16) * ldc + col0;
                f32x4 ls4 = (f32x4){0.f, 0.f, 0.f, 0.f}, lq4 = (f32x4){0.f, 0.f, 0.f, 0.f};
#pragma unroll
                for (int bj = 0; bj < 2; ++bj) { f32x4 v0 = acc[ai][bj][m][0] + bv[bj][0], v1 = acc[ai][bj][m][1] + bv[bj][1];
                    if (act == 1) { v0 = gelu_tanh4(v0); v1 = gelu_tanh4(v1); if (MODE == 0 && seg == 2) { ls4 += v0 + v1; lq4 += v0 * v0 + v1 * v1; } }
                    else if (act == 2) { v0 = sigmoid4(v0); v1 = sigmoid4(v1); }
                    else if (act == 3) { const f32x4 a = __builtin_elementwise_max(v0, (f32x4){0.f, 0.f, 0.f, 0.f}), b = __builtin_elementwise_max(v1, (f32x4){0.f, 0.f, 0.f, 0.f}); v0 = a * a; v1 = b * b; }
                    u32x4 w; w.x = pk2(v0[0], v0[1]); w.y = pk2(v0[2], v0[3]); w.z = pk2(v1[0], v1[1]); w.w = pk2(v1[2], v1[3]);
                    if (MODE == 0) __builtin_nontemporal_store(w, (u32x4*)(rowp + (tiled ? bj * 4 * 512 : bj * HALF)));
                    else if (MODE == 1) __builtin_nontemporal_store(w, (u32x4*)(O + tm_off(row0 + ai * HALF + m * 16, col0 + bj * HALF, ldc)));
                    else *(u32x4*)(rowp + bj * HALF) = w; }
                if (MODE == 0 && seg == 2) {
                    float ls = (ls4.x + ls4.y) + (ls4.z + ls4.w), lq = (lq4.x + lq4.y) + (lq4.z + lq4.w);
                    ls += __shfl_xor(ls, 16); ls += __shfl_xor(ls, 32); lq += __shfl_xor(lq, 16); lq += __shfl_xor(lq, 32);
                    if (fq == 0) *(f32x2*)(part + ((size_t)(row0 + ai * HALF + m * 16) * 16 + (u.pn & 3) * 4 + wc) * 2) = (f32x2){ls, lq};
                } }
    }
};

template <class Epi, class Sched, bool ALIGN_EPI = false, bool SP2 = false>
__device__ __forceinline__ void gemm_phase(LAS unsigned char* lds, const Gemm g, const Sched& S, const Epi& E) {
    int tid_l = threadIdx.x; asm volatile("" : "+v"(tid_l));
    const int tid = tid_l, wid = __builtin_amdgcn_readfirstlane(tid >> 6), lane = tid & 63, wr = wid >> 2, wc = wid & 3, fr = lane & 15, fq = lane >> 4;
    const int K = g.K, nt = K / BK;
    unsigned voffA[2], voffB[2];
#pragma unroll
    for (int i = 0; i < 2; ++i) { const int b = tid * 16 + i * 8192, st = b >> 10;
        voffA[i] = (unsigned)(((st >> 1) * (K >> 5) + (st & 1)) * 1024 + (b & 1023)); voffB[i] = voffA[i]; }
    static_assert(Epi::PERM, "the weight copies are stored row-permuted for PERM epilogues");
    const size_t kstep = (size_t)2048;
    const size_t hstep = (size_t)8 * (K >> 5) * 1024;
    const size_t tstep = 2 * hstep;
    const unsigned ldsw = (unsigned)wid * 1024u;
    const int aoff = lds_byte(wr * 64 + fr, fq * 8), boff = lds_byte(wc * 32 + fr, fq * 8);
#define PG8_SA(b, h) (((b) * 2 + (h)) * HTB)
#define PG8_SB(b, h) ((4 + (b) * 2 + (h)) * HTB)
#define PG8_STAGE(bufoff, gbase, voff) do { _Pragma("unroll") for (int _i = 0; _i < 2; ++_i) \
        __builtin_amdgcn_global_load_lds((const unsigned*)((const char*)(gbase) + (voff)[_i]), (LAS unsigned*)(lds + (bufoff) + ldsw + _i * 8192), 16, 0, 0); } while (0)
#define PG8_LDA(dst, b, h) do { _Pragma("unroll") for (int m = 0; m < 4; ++m) _Pragma("unroll") for (int k = 0; k < 2; ++k) dst[m][k] = *(const LAS bf16x8*)(lds + PG8_SA(b, h) + aoff + m * 2048 + k * 1024); } while (0)
#define PG8_LDB(dst, b, h) do { _Pragma("unroll") for (int n = 0; n < 2; ++n) _Pragma("unroll") for (int k = 0; k < 2; ++k) dst[n][k] = *(const LAS bf16x8*)(lds + PG8_SB(b, h) + boff + n * 2048 + k * 1024); } while (0)
#define PG8_MMA(ai, bj, At, Bt) do { __builtin_amdgcn_s_setprio(1); _Pragma("unroll") for (int m = 0; m < 4; ++m) _Pragma("unroll") for (int n = 0; n < 2; ++n) _Pragma("unroll") for (int k = 0; k < 2; ++k) \
        acc[ai][bj][m][n] = __builtin_amdgcn_mfma_f32_16x16x32_bf16(Bt[n][k], At[m][k], acc[ai][bj][m][n], 0, 0, 0); __builtin_amdgcn_s_setprio(0); } while (0)
#define PG8_WAIT_V(n) asm volatile("s_waitcnt vmcnt(" #n ")" ::: "memory")
#define PG8_WAIT_L(n) asm volatile("s_waitcnt lgkmcnt(" #n ")" ::: "memory")
#define PG8_BAR __builtin_amdgcn_s_barrier()
#define PG8_SCHED __builtin_amdgcn_sched_barrier(0)
    Unit cur, nxt; int ui = 0;
    if (!S.next(0, cur)) return;
    f32x4 acc[2][2][4][2];
#pragma unroll
    for (int a = 0; a < 2; ++a)
#pragma unroll
        for (int b = 0; b < 2; ++b)
#pragma unroll
            for (int m = 0; m < 4; ++m)
#pragma unroll
                for (int n = 0; n < 2; ++n) acc[a][b][m][n] = (f32x4){0.f, 0.f, 0.f, 0.f};
    bf16x8 At[4][2], B0[2][2], B1[2][2];
    const char* cA = (const char*)g.A + (size_t)cur.pm * tstep; const char* cB = (const char*)g.Bt + (size_t)cur.pn * tstep;
    S.a_ready(cur);
    if constexpr (SP2) {
        PG8_STAGE(PG8_SB(0, 0), cB, voffB); PG8_STAGE(PG8_SB(0, 1), cB + hstep, voffB); PG8_STAGE(PG8_SA(0, 0), cA, voffA); PG8_STAGE(PG8_SA(0, 1), cA + hstep, voffA);
        if (wr == 1) PG8_BAR;
        PG8_WAIT_V(2); PG8_BAR;
        PG8_STAGE(PG8_SB(1, 0), cB + kstep, voffB); PG8_STAGE(PG8_SA(1, 0), cA + kstep, voffA); PG8_STAGE(PG8_SB(1, 1), cB + hstep + kstep, voffB);
        PG8_WAIT_V(6); PG8_BAR;
    } else {
        PG8_STAGE(PG8_SB(0, 0), cB, voffB); PG8_STAGE(PG8_SA(0, 0), cA, voffA); PG8_STAGE(PG8_SB(0, 1), cB + hstep, voffB); PG8_STAGE(PG8_SA(0, 1), cA + hstep, voffA);
        if (wr == 1) PG8_BAR;
        PG8_WAIT_V(4); PG8_BAR;
        PG8_STAGE(PG8_SB(1, 0), cB + kstep, voffB); PG8_STAGE(PG8_SA(1, 0), cA + kstep, voffA); PG8_STAGE(PG8_SB(1, 1), cB + hstep + kstep, voffB);
        PG8_WAIT_V(6); PG8_BAR;
    }
    for (;;) {
        const bool has_next = S.next(ui + 1, nxt);
        const char* nA = has_next ? (const char*)g.A + (size_t)nxt.pm * tstep : cA; const char* nB = has_next ? (const char*)g.Bt + (size_t)nxt.pn * tstep : cB;
        for (int t = 0; t < nt; t += 2) {
            const bool last = (t == nt - 2);
            const char* a1 = cA + (size_t)(t + 1) * kstep;
            const char* a2 = last ? nA : cA + (size_t)(t + 2) * kstep; const char* b2 = last ? nB : cB + (size_t)(t + 2) * kstep;
            const char* a3 = a2 + kstep; const char* b3 = b2 + kstep;
            if (last && has_next) S.a_ready(nxt);
            if constexpr (SP2) {
            PG8_LDB(B0, 0, 0); PG8_LDB(B1, 0, 1); PG8_SCHED; PG8_LDA(At, 0, 0); PG8_STAGE(PG8_SA(1, 1), a1 + hstep, voffA);
            PG8_WAIT_V(8); PG8_WAIT_L(0); PG8_BAR; PG8_MMA(0, 0, At, B0); PG8_MMA(0, 1, At, B1); PG8_BAR; PG8_SCHED;
            PG8_LDA(At, 0, 1); PG8_STAGE(PG8_SB(0, 0), b2, voffB); PG8_STAGE(PG8_SB(0, 1), b2 + hstep, voffB); PG8_STAGE(PG8_SA(0, 0), a2, voffA);
            PG8_WAIT_V(8); PG8_WAIT_L(0); PG8_BAR; PG8_MMA(1, 0, At, B0); PG8_MMA(1, 1, At, B1); PG8_BAR; PG8_SCHED;
            PG8_LDB(B0, 1, 0); PG8_LDB(B1, 1, 1); PG8_SCHED; PG8_LDA(At, 1, 0); PG8_STAGE(PG8_SA(0, 1), a2 + hstep, voffA);
            PG8_WAIT_V(8); PG8_WAIT_L(0); PG8_BAR; PG8_MMA(0, 0, At, B0); PG8_MMA(0, 1, At, B1); PG8_BAR; PG8_SCHED;
            PG8_LDA(At, 1, 1); PG8_STAGE(PG8_SB(1, 0), b3, voffB); PG8_STAGE(PG8_SB(1, 1), b3 + hstep, voffB); PG8_STAGE(PG8_SA(1, 0), a3, voffA);
            PG8_WAIT_V(8); PG8_WAIT_L(0); PG8_BAR; PG8_MMA(1, 0, At, B0); PG8_MMA(1, 1, At, B1); PG8_BAR; PG8_SCHED;
            } else {
            PG8_LDB(B0, 0, 0); PG8_SCHED; PG8_LDA(At, 0, 0); PG8_STAGE(PG8_SA(1, 1), a1 + hstep, voffA);
            PG8_WAIT_L(8); PG8_BAR; PG8_WAIT_L(0); PG8_MMA(0, 0, At, B0); PG8_BAR; PG8_SCHED;
            PG8_LDB(B1, 0, 1); PG8_STAGE(PG8_SB(0, 0), b2, voffB);
            PG8_BAR; PG8_WAIT_L(0); PG8_MMA(0, 1, At, B1); PG8_BAR;
            PG8_LDA(At, 0, 1); PG8_STAGE(PG8_SA(0, 0), a2, voffA);
            PG8_BAR; PG8_WAIT_L(0); PG8_MMA(1, 0, At, B0); PG8_BAR; PG8_SCHED;
            PG8_STAGE(PG8_SB(0, 1), b2 + hstep, voffB);
            PG8_WAIT_V(6); PG8_BAR; PG8_MMA(1, 1, At, B1); PG8_BAR;
            PG8_LDB(B0, 1, 0); PG8_SCHED; PG8_LDA(At, 1, 0); PG8_STAGE(PG8_SA(0, 1), a2 + hstep, voffA);
            PG8_WAIT_L(8); PG8_BAR; PG8_WAIT_L(0); PG8_MMA(0, 0, At, B0); PG8_BAR; PG8_SCHED;
            PG8_LDB(B1, 1, 1); PG8_STAGE(PG8_SB(1, 0), b3, voffB);
            PG8_BAR; PG8_WAIT_L(0); PG8_MMA(0, 1, At, B1); PG8_BAR;
            PG8_LDA(At, 1, 1); PG8_STAGE(PG8_SA(1, 0), a3, voffA);
            PG8_BAR; PG8_WAIT_L(0); PG8_MMA(1, 0, At, B0); PG8_BAR; PG8_SCHED;
            PG8_STAGE(PG8_SB(1, 1), b3 + hstep, voffB);
            PG8_WAIT_V(6); PG8_BAR; PG8_MMA(1, 1, At, B1); PG8_BAR;
            }
        }
        if constexpr (ALIGN_EPI) { if (wr == 0) PG8_BAR; }
        if constexpr (!Epi::AFTER_DRAIN) { E(acc, cur, wr, wc, fr, fq); S.done(cur); }
        if (!has_next) break;
#pragma unroll
        for (int a = 0; a < 2; ++a)
#pragma unroll
            for (int b = 0; b < 2; ++b)
#pragma unroll
                for (int m = 0; m < 4; ++m)
#pragma unroll
                    for (int n = 0; n < 2; ++n) acc[a][b][m][n] = (f32x4){0.f, 0.f, 0.f, 0.f};
        cur = nxt; cA = nA; cB = nB; ++ui;
        if constexpr (ALIGN_EPI) { if (wr == 1) PG8_BAR; }
    }
    PG8_WAIT_V(0);
    if constexpr (!ALIGN_EPI) { if (wr == 0) PG8_BAR; }
    PG8_BAR;
#undef PG8_SA
#undef PG8_SB
#undef PG8_STAGE
#undef PG8_LDA
#undef PG8_LDB
#undef PG8_MMA
#undef PG8_WAIT_V
#undef PG8_WAIT_L
#undef PG8_BAR
#undef PG8_SCHED
}
}

struct Args {
    const float* x; const float* n1pre; const float* w_in; const float* b_in; const float* w_pool; const float* pool_scale;
    const float* ln_g; const float* ln_b; const float* w_sp; const float* b_sp; const float* w_sgu; const float* w_out;
    const float* n1post; const float* n2pre; const float* w_ff1; const float* w_ff2; const float* n2post;
    float* out; unsigned char* ws;
};

template <bool TILED = false>
__device__ __forceinline__ void p0_transpose_item(const float* W, int K, int N, bf16_t* WT, LAS float* scr, int item, int lane) {
    const int nblk = N / 32, kb = item / nblk, nb = item % nblk, k0 = 64 * kb, n0 = 32 * nb;
    float wv[32];
#pragma unroll
    for (int i = 0; i < 32; ++i) wv[i] = __builtin_nontemporal_load(W + (size_t)(k0 + 2 * i + (lane >> 5)) * N + n0 + (lane & 31));
#pragma unroll
    for (int i = 0; i < 32; ++i) scr[(2 * i + (lane >> 5)) * 33 + (lane & 31)] = wv[i];
    asm volatile("s_waitcnt lgkmcnt(0)" ::: "memory");
    const int c = lane & 7;
#pragma unroll
    for (int j = 0; j < 4; ++j) { const int n = (lane >> 3) + 8 * j; const LAS float* s = scr + (8 * c) * 33 + n;
        u32x4 o; o.x = pk2(s[0 * 33], s[1 * 33]); o.y = pk2(s[2 * 33], s[3 * 33]); o.z = pk2(s[4 * 33], s[5 * 33]); o.w = pk2(s[6 * 33], s[7 * 33]);
        if (TILED) { const int d = n0 + n, kc = (k0 >> 3) + c, T = (d >> 5) * 2 + ((d >> 2) & 1), fr = (((d & 31) >> 3) << 2) | (d & 3);
            *(u32x4*)(WT + ((size_t)(T * (K >> 5) + (kc >> 2)) * 64 + (kc & 3) * 16 + fr) * 8) = o; }
        else { const int nn = n0 + n, x = nn & 31, Rr = (nn & ~31) + 16 * ((x >> 2) & 1) + 4 * (x >> 3) + (x & 3);
            *(u32x4*)(WT + tm_off(Rr, k0 + 8 * c, K)) = o; } }
    asm volatile("s_waitcnt lgkmcnt(0)" ::: "memory");
}
__device__ __forceinline__ void p0_prologue(const Args& a, LAS unsigned char* lds, int wave, int lane) {
    LAS float* scr = (LAS float*)(lds + wave * 16384);
    const int gw = blockIdx.x * NWAVES + wave, NGW = gridDim.x * NWAVES;
    constexpr int I_IN = (DM / 64) * (DIN / 32), I_OUT = (DM / 64) * (DM / 32), I_F1 = (DM / 64) * (DFF / 32), I_F2 = (DFF / 64) * (DM / 32), I_G = (256 / 64) * (256 / 32);
    constexpr int NITEMS = I_IN + I_OUT + I_F1 + I_F2 + 8 * I_G;
    unsigned char* ws = a.ws;
    for (int it = gw; it < NITEMS; it += NGW) {
        int r = it;
        if (r < I_IN) { p0_transpose_item(a.w_in, DM, DIN, (bf16_t*)(ws + WS_WIN), scr, r, lane); continue; } r -= I_IN;
        if (r < I_OUT) { p0_transpose_item(a.w_out, DM, DM, (bf16_t*)(ws + WS_WOUT), scr, r, lane); continue; } r -= I_OUT;
        if (r < I_F1) { p0_transpose_item(a.w_ff1, DM, DFF, (bf16_t*)(ws + WS_WFF1), scr, r, lane); continue; } r -= I_F1;
        if (r < I_F2) { p0_transpose_item(a.w_ff2, DFF, DM, (bf16_t*)(ws + WS_WFF2), scr, r, lane); continue; } r -= I_F2;
        const int gsel = r / I_G, ri = r % I_G;
        if (gsel < 4) p0_transpose_item<true>(a.w_pool + (size_t)gsel * 65536, 256, 256, (bf16_t*)(ws + WS_WPOOL) + (size_t)gsel * 65536, scr, ri, lane);
        else p0_transpose_item<true>(a.w_sgu + (size_t)(gsel - 4) * 65536, 256, 256, (bf16_t*)(ws + WS_WSGU) + (size_t)(gsel - 4) * 65536, scr, ri, lane);
    }
    { unsigned* bw = (unsigned*)(ws + WS_BAR); for (int e = blockIdx.x * 512 + threadIdx.x; e < 3456; e += gridDim.x * 512) bw[e] = 0u; }
    { bf16_t* wsp = (bf16_t*)(ws + WS_WSP);
      for (int e = (blockIdx.x * 512 + threadIdx.x); e < 4 * 128 * 128; e += gridDim.x * 512) { const int i = (e >> 7) & 127, j = e & 127; const float v = ((i >> 6) >= (j >> 6)) ? a.w_sp[e] : 0.f;
          wsp[((size_t)(((e >> 14) * 8 + (i >> 4)) * 4 + (j >> 5)) * 64 + ((j >> 3) & 3) * 16 + (i & 15)) * 8 + (j & 7)] = (bf16_t)f2bf(v); } }
    bf16_t* XN = (bf16_t*)(ws + WS_R1);
    f32x4 gv[4];
#pragma unroll
    for (int j = 0; j < 2; ++j) { gv[2 * j] = *(const f32x4*)(a.n1pre + 512 * j + 8 * lane); gv[2 * j + 1] = *(const f32x4*)(a.n1pre + 512 * j + 8 * lane + 4); }
    for (int m0 = gw * 2; m0 < M; m0 += NGW * 2) {
        f32x4 v[2][4];
#pragma unroll
        for (int r = 0; r < 2; ++r) { const float* xr = a.x + (size_t)(m0 + r) * DM + 8 * lane;
            v[r][0] = __builtin_nontemporal_load((const f32x4*)(xr)); v[r][1] = __builtin_nontemporal_load((const f32x4*)(xr + 4)); v[r][2] = __builtin_nontemporal_load((const f32x4*)(xr + 512)); v[r][3] = __builtin_nontemporal_load((const f32x4*)(xr + 516)); }
#pragma unroll
        for (int r = 0; r < 2; ++r) {
            float s = 0.f;
#pragma unroll
            for (int j = 0; j < 4; ++j) s += (v[r][j].x * v[r][j].x + v[r][j].y * v[r][j].y) + (v[r][j].z * v[r][j].z + v[r][j].w * v[r][j].w);
            const float rstd = 1.0f / sqrtf(wave_sum(s) * (1.f / DM) + EPS);
#pragma unroll
            for (int j = 0; j < 2; ++j) { const f32x4 t0 = v[r][2 * j] * rstd * gv[2 * j], t1 = v[r][2 * j + 1] * rstd * gv[2 * j + 1];
                u32x4 w; w.x = pk2(t0.x, t0.y); w.y = pk2(t0.z, t0.w); w.z = pk2(t1.x, t1.y); w.w = pk2(t1.z, t1.w); *(u32x4*)(XN + tm_off(m0 + r, 512 * j + 8 * lane, DM)) = w; }
        }
    }
}

template <int W>
__device__ __forceinline__ void pool_tile(int pos0, LAS unsigned char* Ps, int tid) {
    const int c4 = (tid & 63) * 4, r0 = (tid >> 6) * 16;
    const LAS unsigned char* src = Ps + (r0 + 15 - (W - 1)) * VS_STRIDE + c4 * 2;
    u32x2 hist[W - 1 + 16];
#pragma unroll
    for (int s = 0; s < W - 1 + 16; ++s) hist[s] = *(const LAS u32x2*)(src + s * VS_STRIDE);
    __syncthreads();
    float S0 = 0.f, S1 = 0.f, S2 = 0.f, S3 = 0.f;
#pragma unroll
    for (int s = 0; s < W - 1; ++s) { const u32x2 v = hist[s]; S0 += bf_lo(v.x); S1 += bf_hi(v.x); S2 += bf_lo(v.y); S3 += bf_hi(v.y); }
#pragma unroll
    for (int t = 0; t < 16; ++t) {
        const u32x2 v = hist[W - 1 + t];
        const float p0 = bf_lo(v.x), p1 = bf_hi(v.x), p2 = bf_lo(v.y), p3 = bf_hi(v.y);
        S0 += p0; S1 += p1; S2 += p2; S3 += p3;
        const int pos = pos0 + r0 + t; const float inv = (pos + 1 < W) ? __builtin_amdgcn_rcpf((float)(pos + 1)) : (1.0f / W);
        u32x2 o; o.x = pk2(S0 * inv - p0, S1 * inv - p1); o.y = pk2(S2 * inv - p2, S3 * inv - p3);
        *(LAS u32x2*)(Ps + (r0 + t) * VS_STRIDE + c4 * 2) = o;
        const u32x2 old = hist[t];
        S0 -= bf_lo(old.x); S1 -= bf_hi(old.x); S2 -= bf_lo(old.y); S3 -= bf_hi(old.y);
    }
}

__device__ __forceinline__ void mixer_phase(const Args& a, LAS unsigned char* lds, int tid_, int wave, int lane_) {
    const bf16_t* Z = (const bf16_t*)(a.ws + WS_Z);
    const bf16_t* ZU = Z + (size_t)M * 1024; const bf16_t* ZV = Z + 2 * (size_t)M * 1024; const bf16_t* ZGA = Z + 3 * (size_t)M * 1024; const bf16_t* ZGB = Z + 4 * (size_t)M * 1024;
    bf16_t* MG = (bf16_t*)(a.ws + WS_R2);
    const bf16_t* Wsp = (const bf16_t*)(a.ws + WS_WSP);
    const bf16_t* Wpool = (const bf16_t*)(a.ws + WS_WPOOL);
    const bf16_t* Wsgu = (const bf16_t*)(a.ws + WS_WSGU);
    LAS unsigned char* Vs = lds + MX_VS; LAS unsigned char* Ps = lds + MX_PS; LAS f32x2* ST = (LAS f32x2*)(lds + MX_ST);
    const int wr = wave >> 2, wc = wave & 3;
    for (int unit = blockIdx.x; unit < M / SBLK; unit += gridDim.x) {
        const int tok0 = unit * SBLK, pos0_ = tok0 % SEQ; const int lane = lane_;
        if (tid_ < 128) {
            const f32x4* pp = (const f32x4*)((const float*)(a.ws + WS_PART) + (size_t)(tok0 + tid_) * 32);
            float sm = 0.f, q = 0.f;
#pragma unroll
            for (int k = 0; k < 8; ++k) { const f32x4 t = pp[k]; sm += t.x + t.z; q += t.y + t.w; }
            const float mean = sm * (1.f / 1024.f), var = fmaxf(q * (1.f / 1024.f) - mean * mean, 0.f);
            ST[tid_] = (f32x2){mean, 1.0f / sqrtf(var + EPS)};
        }
        __syncthreads();
#pragma unroll 1
        for (int h = 0; h < 4; ++h) {
            int tid = tid_, pos0 = pos0_;
            asm volatile("" : "+v"(tid)); asm volatile("" : "+s"(pos0));
            const int lane = tid & 63, fr = lane & 15, fq = lane >> 4;
            {
                const int ch = (tid & 31) * 8, rg = (tid >> 5) * 8;
                u32x4 pr[9], vv[8];
#pragma unroll
                for (int k = 0; k < 9; ++k) {
                    int rr = (tid + k * 512) >> 5; rr = rr > 142 ? 142 : rr;
                    int grow = tok0 + rr - 15; grow = grow < 0 ? 0 : grow;
                    pr[k] = __builtin_nontemporal_load((const u32x4*)(Z + (size_t)grow * 1024 + h * 256 + ch));
                }
#pragma unroll
                for (int rr = 0; rr < 8; ++rr) vv[rr] = __builtin_nontemporal_load((const u32x4*)(ZV + (size_t)(tok0 + rg + rr) * 1024 + h * 256 + ch));
                const f32x4 g0 = *(const f32x4*)(a.ln_g + h * 256 + ch), g1 = *(const f32x4*)(a.ln_g + h * 256 + ch + 4);
                const f32x4 b0 = *(const f32x4*)(a.ln_b + h * 256 + ch), b1 = *(const f32x4*)(a.ln_b + h * 256 + ch + 4);
#pragma unroll
                for (int k = 0; k < 9; ++k) {
                    const int idx = tid + k * 512, rr = idx >> 5;
                    if (idx < 143 * 32) { const u32x4 v = (pos0 + rr - 15 >= 0) ? pr[k] : (u32x4){0u, 0u, 0u, 0u}; *(LAS u32x4*)(Ps + rr * VS_STRIDE + ch * 2) = v; }
                }
#pragma unroll
                for (int rr = 0; rr < 8; ++rr) {
                    const int r = rg + rr; const f32x2 st = ST[r]; const u32x4 v = vv[rr];
                    f32x4 lo = (f32x4){bf_lo(v.x), bf_hi(v.x), bf_lo(v.y), bf_hi(v.y)}, hi = (f32x4){bf_lo(v.z), bf_hi(v.z), bf_lo(v.w), bf_hi(v.w)};
                    lo = (lo - st.x) * st.y * g0 + b0; hi = (hi - st.x) * st.y * g1 + b1;
                    u32x4 o; o.x = pk2(lo.x, lo.y); o.y = pk2(lo.z, lo.w); o.z = pk2(hi.x, hi.y); o.w = pk2(hi.z, hi.w);
                    *(LAS u32x4*)(Vs + r * VS_STRIDE + ch * 2) = o;
                }
            }
            __syncthreads();
            if (h == 0) pool_tile<2>(pos0, Ps, tid);
            else if (h == 1) pool_tile<4>(pos0, Ps, tid);
            else if (h == 2) pool_tile<8>(pos0, Ps, tid);
            else pool_tile<16>(pos0, Ps, tid);
            __syncthreads();
            f32x4 acc[4][4];
            u32x4 uu[4][2];
            float bs[4];
#pragma unroll
            for (int x = 0; x < 4; ++x)
#pragma unroll
                for (int y = 0; y < 4; ++y) acc[x][y] = (f32x4){0.f, 0.f, 0.f, 0.f};
            {
                const int li = lane & 15, q = li >> 2, p = li & 3;
                const int nks = (wr == 0) ? 2 : 4;
                bf16x8 wq[4][4];
                const bf16_t* wb = Wsp + ((size_t)(h * 8 + wr * 4) * 4 * 64 + lane) * 8;
#pragma unroll
                for (int ks = 0; ks < 4; ++ks)
                    if (ks < nks) {
#pragma unroll
                        for (int it = 0; it < 4; ++it) wq[ks][it] = *(const bf16x8*)(wb + (it * 4 + ks) * 512);
                    }
#pragma unroll
                for (int it = 0; it < 4; ++it) {
                    const int i = wr * 64 + it * 16 + fr; bs[it] = a.b_sp[h * 128 + i];
                    const bf16_t* ur = ZU + ((size_t)((tok0 + wr * 64 + it * 16) >> 4) * 32 + h * 8 + wc * 2) * 512 + lane * 8;
#pragma unroll
                    for (int cp = 0; cp < 2; ++cp) uu[it][cp] = __builtin_nontemporal_load((const u32x4*)(ur + cp * 512));
                }
#pragma unroll
                for (int ks = 0; ks < 4; ++ks)
                    if (ks < nks) {
                        bf16x8 pv[4];
#pragma unroll
                        for (int ct = 0; ct < 4; ++ct) {
                            const LAS unsigned char* ad = Vs + (ks * 32 + 8 * fq + q) * VS_STRIDE + (wc * 64 + (ct >> 1) * 32 + 8 * p + 4 * (ct & 1)) * 2;
                            const s16x4 t0 = __builtin_bit_cast(s16x4, __builtin_amdgcn_ds_read_tr16_b64_v4i16((LAS s16x4*)ad));
                            const s16x4 t1 = __builtin_bit_cast(s16x4, __builtin_amdgcn_ds_read_tr16_b64_v4i16((LAS s16x4*)(ad + 4 * VS_STRIDE)));
                            pv[ct] = (bf16x8){t0[0], t0[1], t0[2], t0[3], t1[0], t1[1], t1[2], t1[3]};
                        }
#pragma unroll
                        for (int ct = 0; ct < 4; ++ct)
#pragma unroll
                            for (int it = 0; it < 4; ++it) acc[ct][it] = __builtin_amdgcn_mfma_f32_16x16x32_bf16(pv[ct], wq[ks][it], acc[ct][it], 0, 0, 0);
                    }
            }
            __syncthreads();
#pragma unroll
            for (int it = 0; it < 4; ++it) {
                const int i = wr * 64 + it * 16 + fr; const float b = bs[it];
#pragma unroll
                for (int cp = 0; cp < 2; ++cp) {
                    const int c = wc * 64 + cp * 32 + 8 * fq;
                    const u32x4 u4 = uu[it][cp]; const f32x4 s0 = acc[2 * cp][it], s1 = acc[2 * cp + 1][it];
                    u32x4 o; o.x = pk2(bf_lo(u4.x) * (s0[0] + b), bf_hi(u4.x) * (s0[1] + b)); o.y = pk2(bf_lo(u4.y) * (s0[2] + b), bf_hi(u4.y) * (s0[3] + b));
                    o.z = pk2(bf_lo(u4.z) * (s1[0] + b), bf_hi(u4.z) * (s1[1] + b)); o.w = pk2(bf_lo(u4.w) * (s1[2] + b), bf_hi(u4.w) * (s1[3] + b));
                    *(LAS u32x4*)(Vs + i * VS_STRIDE + c * 2) = o;
                }
            }
            __syncthreads();
#pragma unroll 1
            for (int dh = 0; dh < 2; ++dh) {
                f32x4 aca[2][4], acb[2][4];
                u32x4 ga[4], gb[4];
#pragma unroll
                for (int x = 0; x < 2; ++x)
#pragma unroll
                    for (int y = 0; y < 4; ++y) { aca[x][y] = (f32x4){0.f, 0.f, 0.f, 0.f}; acb[x][y] = (f32x4){0.f, 0.f, 0.f, 0.f}; }
                const size_t wtoff = ((size_t)(h * 16 + (wc * 2 + dh) * 2) * 8 * 64 + lane) * 8;
                const bf16_t* wpb = Wpool + wtoff;
                const bf16_t* wgb = Wsgu + wtoff;
                const int qoff = (wr * 64 + fr) * VS_STRIDE + fq * 16;
                const int d0 = h * 256 + wc * 64 + dh * 32 + 8 * fq;
                bf16x8 w[2][8];
#pragma unroll
                for (int dt = 0; dt < 2; ++dt)
#pragma unroll
                    for (int ks = 0; ks < 8; ++ks) w[dt][ks] = *(const bf16x8*)(wpb + (dt * 8 + ks) * 512);
#pragma unroll
                for (int it = 0; it < 4; ++it) {
                    const size_t toff = ((size_t)((tok0 + wr * 64 + it * 16) >> 4) * 32 + h * 8 + wc * 2 + dh) * 512 + lane * 8;
                    ga[it] = __builtin_nontemporal_load((const u32x4*)(ZGA + toff)); gb[it] = __builtin_nontemporal_load((const u32x4*)(ZGB + toff));
                }
#pragma unroll
                for (int ks = 0; ks < 8; ++ks) {
                    bf16x8 qa[4];
#pragma unroll
                    for (int it = 0; it < 4; ++it) qa[it] = *(const LAS bf16x8*)(Ps + qoff + it * 16 * VS_STRIDE + ks * 64);
#pragma unroll
                    for (int dt = 0; dt < 2; ++dt)
#pragma unroll
                        for (int it = 0; it < 4; ++it) aca[dt][it] = __builtin_amdgcn_mfma_f32_16x16x32_bf16(w[dt][ks], qa[it], aca[dt][it], 0, 0, 0);
                }
                { const bf16_t* wgl = wgb; asm volatile("" : "+v"(wgl));
#pragma unroll
                for (int dt = 0; dt < 2; ++dt)
#pragma unroll
                    for (int ks = 0; ks < 8; ++ks) w[dt][ks] = *(const bf16x8*)(wgl + (dt * 8 + ks) * 512); }
#pragma unroll
                for (int ks = 0; ks < 8; ++ks) {
                    bf16x8 qb[4];
#pragma unroll
                    for (int it = 0; it < 4; ++it) qb[it] = *(const LAS bf16x8*)(Vs + qoff + it * 16 * VS_STRIDE + ks * 64);
#pragma unroll
                    for (int dt = 0; dt < 2; ++dt)
#pragma unroll
                        for (int it = 0; it < 4; ++it) acb[dt][it] = __builtin_amdgcn_mfma_f32_16x16x32_bf16(w[dt][ks], qb[it], acb[dt][it], 0, 0, 0);
                }
                {
                    const f32x4 ps0 = *(const f32x4*)(a.pool_scale + d0), ps1 = *(const f32x4*)(a.pool_scale + d0 + 4);
#pragma unroll
                    for (int it = 0; it < 4; ++it) {
                        const int i = wr * 64 + it * 16 + fr;
                        const u32x4 g1 = ga[it], g2 = gb[it];
                        const f32x4 A0 = aca[0][it], B0 = acb[0][it], A1 = aca[1][it], B1 = acb[1][it];
                        u32x4 o;
                        o.x = pk2(bf_lo(g1.x) * ps0[0] * A0[0] + bf_lo(g2.x) * B0[0], bf_hi(g1.x) * ps0[1] * A0[1] + bf_hi(g2.x) * B0[1]);
                        o.y = pk2(bf_lo(g1.y) * ps0[2] * A0[2] + bf_lo(g2.y) * B0[2], bf_hi(g1.y) * ps0[3] * A0[3] + bf_hi(g2.y) * B0[3]);
                        o.z = pk2(bf_lo(g1.z) * ps1[0] * A1[0] + bf_lo(g2.z) * B1[0], bf_hi(g1.z) * ps1[1] * A1[1] + bf_hi(g2.z) * B1[1]);
                        o.w = pk2(bf_lo(g1.w) * ps1[2] * A1[2] + bf_lo(g2.w) * B1[2], bf_hi(g1.w) * ps1[3] * A1[3] + bf_hi(g2.w) * B1[3]);
                        *(u32x4*)(MG + tm_off(tok0 + i, d0, DM)) = o;
                    }
                }
            }
            __syncthreads();
        }
    }
}

__device__ __forceinline__ void unpack8(const u32x4 v, f32x4& lo, f32x4& hi) { lo = (f32x4){bf_lo(v.x), bf_hi(v.x), bf_lo(v.y), bf_hi(v.y)}; hi = (f32x4){bf_lo(v.z), bf_hi(v.z), bf_lo(v.w), bf_hi(v.w)}; }
__device__ __forceinline__ float ssq4(const f32x4 v) { return (v.x * v.x + v.y * v.y) + (v.z * v.z + v.w * v.w); }
__device__ __forceinline__ void rows_mid(const Args& a, int wave, int lane) {
    const bf16_t* Y = (const bf16_t*)(a.ws + WS_Y); bf16_t* HN = (bf16_t*)(a.ws + WS_R1);
    const int gw = blockIdx.x * NWAVES + wave, NGW = gridDim.x * NWAVES;
    f32x4 g1[4], g2[4];
#pragma unroll
    for (int j = 0; j < 2; ++j) { const int c = 512 * j + 8 * lane;
        g1[2 * j] = *(const f32x4*)(a.n1post + c); g1[2 * j + 1] = *(const f32x4*)(a.n1post + c + 4); g2[2 * j] = *(const f32x4*)(a.n2pre + c); g2[2 * j + 1] = *(const f32x4*)(a.n2pre + c + 4); }
    for (int m0 = gw * 2; m0 < M; m0 += NGW * 2) {
        u32x4 yb[2][2]; f32x4 xx[2][4];
#pragma unroll
        for (int r = 0; r < 2; ++r) { const u32x4* yr = (const u32x4*)(Y + (size_t)(m0 + r) * DM) + lane; const float* xr = a.x + (size_t)(m0 + r) * DM + 8 * lane;
            yb[r][0] = __builtin_nontemporal_load(yr); yb[r][1] = __builtin_nontemporal_load(yr + 64);
            xx[r][0] = __builtin_nontemporal_load((const f32x4*)(xr)); xx[r][1] = __builtin_nontemporal_load((const f32x4*)(xr + 4)); xx[r][2] = __builtin_nontemporal_load((const f32x4*)(xr + 512)); xx[r][3] = __builtin_nontemporal_load((const f32x4*)(xr + 516)); }
#pragma unroll
        for (int r = 0; r < 2; ++r) {
            f32x4 y[4]; float s = 0.f;
            unpack8(yb[r][0], y[0], y[1]); unpack8(yb[r][1], y[2], y[3]);
#pragma unroll
            for (int j = 0; j < 4; ++j) s += ssq4(y[j]);
            const float rstd = 1.0f / sqrtf(wave_sum(s) * (1.f / DM) + EPS);
            float s2 = 0.f;
#pragma unroll
            for (int j = 0; j < 4; ++j) { xx[r][j] = xx[r][j] + y[j] * rstd * g1[j]; s2 += ssq4(xx[r][j]); }
            const float rstd2 = 1.0f / sqrtf(wave_sum(s2) * (1.f / DM) + EPS);
            u32x4* oh = (u32x4*)(a.ws + WS_Y) + (size_t)(m0 + r) * (DM / 8) + lane;
#pragma unroll
            for (int j = 0; j < 2; ++j) { const f32x4 t0 = xx[r][2 * j], t1 = xx[r][2 * j + 1];
                u32x4 w; w.x = pk2(t0.x, t0.y); w.y = pk2(t0.z, t0.w); w.z = pk2(t1.x, t1.y); w.w = pk2(t1.z, t1.w); __builtin_nontemporal_store(w, oh + 64 * j); }
#pragma unroll
            for (int j = 0; j < 2; ++j) { const f32x4 t0 = xx[r][2 * j] * rstd2 * g2[2 * j], t1 = xx[r][2 * j + 1] * rstd2 * g2[2 * j + 1];
                u32x4 w; w.x = pk2(t0.x, t0.y); w.y = pk2(t0.z, t0.w); w.z = pk2(t1.x, t1.y); w.w = pk2(t1.z, t1.w); *(u32x4*)(HN + tm_off(m0 + r, 512 * j + 8 * lane, DM)) = w; }
        }
    }
}
__device__ __forceinline__ void rows_final(const Args& a, int wave, int lane) {
    const bf16_t* H1 = (const bf16_t*)(a.ws + WS_Y); const bf16_t* F2 = (const bf16_t*)(a.ws + WS_R2);
    const int gw = blockIdx.x * NWAVES + wave, NGW = gridDim.x * NWAVES;
    f32x4 g2[4];
#pragma unroll
    for (int j = 0; j < 2; ++j) { const int c = 512 * j + 8 * lane; g2[2 * j] = *(const f32x4*)(a.n2post + c); g2[2 * j + 1] = *(const f32x4*)(a.n2post + c + 4); }
    for (int m0 = gw * 2; m0 < M; m0 += NGW * 2) {
        u32x4 hb[2][2], fb[2][2];
#pragma unroll
        for (int r = 0; r < 2; ++r) { const u32x4* hr = (const u32x4*)(H1 + (size_t)(m0 + r) * DM) + lane; const u32x4* fr_ = (const u32x4*)(F2 + (size_t)(m0 + r) * DM) + lane;
            hb[r][0] = __builtin_nontemporal_load(hr); hb[r][1] = __builtin_nontemporal_load(hr + 64); fb[r][0] = __builtin_nontemporal_load(fr_); fb[r][1] = __builtin_nontemporal_load(fr_ + 64); }
#pragma unroll
        for (int r = 0; r < 2; ++r) {
            f32x4 h[4], f[4]; float q = 0.f;
            unpack8(hb[r][0], h[0], h[1]); unpack8(hb[r][1], h[2], h[3]); unpack8(fb[r][0], f[0], f[1]); unpack8(fb[r][1], f[2], f[3]);
#pragma unroll
            for (int j = 0; j < 4; ++j) q += ssq4(f[j]);
            const float rq = 1.0f / sqrtf(wave_sum(q) * (1.f / DM) + EPS);
            float* orow = a.out + (size_t)(m0 + r) * DM + 8 * lane;
#pragma unroll
            for (int j = 0; j < 4; ++j) h[j] = h[j] + f[j] * rq * g2[j];
            *(f32x4*)(orow) = h[0]; *(f32x4*)(orow + 4) = h[1]; *(f32x4*)(orow + 512) = h[2]; *(f32x4*)(orow + 516) = h[3];
        }
    }
}

#define XB_TMO      128
#define XB_XCNT(j)  (256  + 64 * (j))
#define XB_XSUB(j)  (1280 + 64 * (j))
#define XB_XGEN(j)  (2304 + 64 * (j))
#define XB_TOP      3328
#define XB_TOPGEN   3392
#define XCD_BAR_WORDS 3456
#define XB_SPIN_CAP (1u << 18)
__device__ __forceinline__ unsigned xb_ld(unsigned* p)              { return __hip_atomic_load(p, __ATOMIC_RELAXED, __HIP_MEMORY_SCOPE_AGENT); }
__device__ __forceinline__ unsigned xb_add(unsigned* p, unsigned v) { return __hip_atomic_fetch_add(p, v, __ATOMIC_RELAXED, __HIP_MEMORY_SCOPE_AGENT); }
__device__ __forceinline__ unsigned xb_xcc_id() { return (unsigned)__builtin_amdgcn_s_getreg((3 << 11) | 20) & 0xFu; }
#define XB_SPIN(cond, bar) do { unsigned _sp = 0; while (cond) { __builtin_amdgcn_s_sleep(1); \
    if ((++_sp & 255u) == 0u) { if (xb_ld(&(bar)[XB_TMO])) break; if (_sp > XB_SPIN_CAP) { atomicAdd(&(bar)[XB_TMO], 1u); break; } } } } while (0)
struct XcdBarrier { unsigned* bar; unsigned x; volatile LAS unsigned* st; };
__device__ __forceinline__ XcdBarrier xcd_barrier_post(unsigned* bar, volatile LAS unsigned* st) {
    XcdBarrier b; b.bar = bar; b.x = xb_xcc_id(); b.st = st;
    if (threadIdx.x == 0) (void)xb_add(&bar[XB_XCNT(b.x)], 1u);
    return b;
}
__device__ __forceinline__ void xcd_barrier_complete(unsigned* bar, unsigned x, unsigned& nloc, unsigned& nx) {
    const unsigned G = gridDim.x * gridDim.y * gridDim.z;
    unsigned sum, cnt, mine, sp = 0u;
    for (;;) {
        sum = 0u; cnt = 0u; mine = 0u;
#pragma unroll
        for (unsigned j = 0; j < 16; ++j) { const unsigned c = xb_ld(&bar[XB_XCNT(j)]); sum += c; cnt += (c > 0u) ? 1u : 0u; mine = (j == x) ? c : mine; }
        if (sum == G) break;
        __builtin_amdgcn_s_sleep(1);
        if ((++sp & 255u) == 0u) { if (xb_ld(&bar[XB_TMO])) break; if (sp > XB_SPIN_CAP) { atomicAdd(&bar[XB_TMO], 1u); break; } }
    }
    nloc = mine > 0u ? mine : 1u; nx = cnt > 0u ? cnt : 1u;
}
__device__ __forceinline__ void xcd_barrier(const XcdBarrier& b) {
    asm volatile("s_waitcnt vmcnt(0)" ::: "memory");
    __syncthreads();
    if (threadIdx.x == 0) {
        unsigned* bar = b.bar;
        __builtin_amdgcn_s_waitcnt(0);
        unsigned nloc = b.st[0], nx = b.st[1];
        if (nloc == 0u) { xcd_barrier_complete(bar, b.x, nloc, nx); b.st[0] = nloc; b.st[1] = nx; }
        const unsigned old = xb_add(&bar[XB_XSUB(b.x)], 1u);
        const unsigned gen = old / nloc;
        if (old + 1u == (gen + 1u) * nloc) {
            __builtin_amdgcn_fence(__ATOMIC_RELEASE, "agent");
            asm volatile("s_waitcnt vmcnt(0)" ::: "memory");
            const unsigned og = xb_add(&bar[XB_TOP], 1u);
            const unsigned tg = og / nx;
            if (og + 1u == (tg + 1u) * nx) xb_add(&bar[XB_TOPGEN], 1u);
            else XB_SPIN(xb_ld(&bar[XB_TOPGEN]) == tg, bar);
            __builtin_amdgcn_fence(__ATOMIC_ACQUIRE, "agent");
            xb_add(&bar[XB_XGEN(b.x)], 1u);
            asm volatile("s_waitcnt vmcnt(0)" ::: "memory");
        } else {
            XB_SPIN(xb_ld(&bar[XB_XGEN(b.x)]) == gen, bar);
            __builtin_amdgcn_fence(__ATOMIC_ACQUIRE, "agent");
            asm volatile("s_waitcnt vmcnt(0)" ::: "memory");
        }
    }
    __syncthreads();
}

__global__ void __launch_bounds__(NWAVES * 64, 2) fwd_megakernel(Args args) {
    extern __shared__ __attribute__((aligned(16))) unsigned char lds_raw[];
    cg::grid_group grid = cg::this_grid();
    LAS unsigned char* lds = (LAS unsigned char*)lds_raw;
    const int tid = threadIdx.x, lane = tid & 63, wave = __builtin_amdgcn_readfirstlane(tid >> 6);
    unsigned char* ws = args.ws;
    const int G = gridDim.x, c = blockIdx.x;
    volatile LAS unsigned* xst = (volatile LAS unsigned*)(lds + LDS_BYTES - 16);
    if (tid < 4) xst[tid] = 0u;
    __syncthreads();

#ifndef NO_P0
    p0_prologue(args, lds, wave, lane);
#endif
    grid.sync();
    XcdBarrier xbar = xcd_barrier_post((unsigned*)(ws + WS_BAR), xst);
    {
        pg8::Gemm g{(const bf16_t*)(ws + WS_R1), (const bf16_t*)(ws + WS_WIN), M, DIN, DM}; pg8::StaticOrder S; S.init(M, DIN, G, c);
        pg8::EpiBf16<0> E{(bf16_t*)(ws + WS_Z), DIN, args.b_in, (float*)(ws + WS_PART)};
        pg8::gemm_phase<pg8::EpiBf16<0>, pg8::StaticOrder, true, true>(lds, g, S, E);
    }
    xcd_barrier(xbar);
#ifndef NO_MIX
    mixer_phase(args, lds, tid, wave, lane);
#endif
    xcd_barrier(xbar);
    {
        pg8::Gemm g{(const bf16_t*)(ws + WS_R2), (const bf16_t*)(ws + WS_WOUT), M, DM, DM}; pg8::StaticOrder S; S.init(M, DM, G, c);
        pg8::EpiBf16<2> E{(bf16_t*)(ws + WS_Y), DM, nullptr, nullptr};
        pg8::gemm_phase<pg8::EpiBf16<2>, pg8::StaticOrder, true, true>(lds, g, S, E);
    }
    xcd_barrier(xbar);
#ifndef NO_ROWS
    rows_mid(args, wave, lane);
#endif
    xcd_barrier(xbar);
    {
        pg8::Gemm g{(const bf16_t*)(ws + WS_R1), (const bf16_t*)(ws + WS_WFF1), M, DFF, DM}; pg8::StaticOrder S; S.init(M, DFF, G, c);
        pg8::EpiBf16<1> E{(bf16_t*)(ws + WS_Z), DFF, nullptr, nullptr};
        pg8::gemm_phase<pg8::EpiBf16<1>, pg8::StaticOrder, true, true>(lds, g, S, E);
    }
    xcd_barrier(xbar);
    {
        pg8::Gemm g{(const bf16_t*)(ws + WS_Z), (const bf16_t*)(ws + WS_WFF2), M, DM, DFF}; pg8::StaticOrder S; S.init(M, DM, G, c);
        pg8::EpiBf16<2> E{(bf16_t*)(ws + WS_R2), DM, nullptr, nullptr};
        pg8::gemm_phase<pg8::EpiBf16<2>, pg8::StaticOrder, true, true>(lds, g, S, E);
    }
    xcd_barrier(xbar);
#ifndef NO_ROWS
    rows_final(args, wave, lane);
#endif
}

extern "C" void kernel_launch(void* const* d_in, const int* in_sizes, int n_in, void* d_out, int out_size, void* d_ws, size_t ws_size, hipStream_t stream) {
    static int grid = 0;
    if (grid == 0) {
        if (n_in != 17 || in_sizes[0] != M * DM || out_size != M * DM || ws_size < WS_END) { fprintf(stderr, "kernel_launch: unexpected shapes (n_in %d in0 %d out %d ws %zu)\n", n_in, n_in > 0 ? in_sizes[0] : -1, out_size, ws_size); grid = -1; return; }
        int dev = 0, cus = 0, per_cu = 0;
        hipGetDevice(&dev);
        hipDeviceGetAttribute(&cus, hipDeviceAttributeMultiprocessorCount, dev);
        if (hipFuncSetAttribute((const void*)fwd_megakernel, hipFuncAttributeMaxDynamicSharedMemorySize, LDS_BYTES) != hipSuccess) { fprintf(stderr, "kernel_launch: hipFuncSetAttribute failed\n"); grid = -1; return; }
        if (hipOccupancyMaxActiveBlocksPerMultiprocessor(&per_cu, (const void*)fwd_megakernel, NWAVES * 64, LDS_BYTES) != hipSuccess || per_cu < 1) { fprintf(stderr, "kernel_launch: occupancy query says %d\n", per_cu); per_cu = 1; }
        (void)hipGetLastError();
        grid = cus * per_cu;
    }
    if (grid < 0) return;
    Args a{};
    a.x = (const float*)d_in[0]; a.n1pre = (const float*)d_in[1]; a.w_in = (const float*)d_in[2]; a.b_in = (const float*)d_in[3];
    a.w_pool = (const float*)d_in[4]; a.pool_scale = (const float*)d_in[5]; a.ln_g = (const float*)d_in[6]; a.ln_b = (const float*)d_in[7];
    a.w_sp = (const float*)d_in[8]; a.b_sp = (const float*)d_in[9]; a.w_sgu = (const float*)d_in[10]; a.w_out = (const float*)d_in[11];
    a.n1post = (const float*)d_in[12]; a.n2pre = (const float*)d_in[13]; a.w_ff1 = (const float*)d_in[14]; a.w_ff2 = (const float*)d_in[15]; a.n2post = (const float*)d_in[16];
    a.out = (float*)d_out; a.ws = (unsigned char*)d_ws;
    void* kargs[] = {&a};
    hipError_t e = hipLaunchCooperativeKernel((const void*)fwd_megakernel, dim3(grid), dim3(NWAVES * 64), kargs, LDS_BYTES, stream);
    if (e != hipSuccess) fprintf(stderr, "kernel_launch: cooperative launch failed: %s (grid %d)\n", hipGetErrorString(e), grid);
}
```

```cpp
#include <hip/hip_runtime.h>
#include <hip/hip_cooperative_groups.h>
#include <cstdio>
#include <cstdint>
namespace cg = cooperative_groups;

#define LAS __attribute__((address_space(3)))
typedef unsigned short bf16_t;
typedef short bf16x8 __attribute__((ext_vector_type(8)));
typedef short s16x4 __attribute__((ext_vector_type(4)));
typedef float f32x4 __attribute__((ext_vector_type(4)));
typedef float f32x2 __attribute__((ext_vector_type(2)));
typedef unsigned u32x4 __attribute__((ext_vector_type(4)));
typedef unsigned u32x2 __attribute__((ext_vector_type(2)));

constexpr int DM = 1024, NB = 8, SEQ = 4096, M = NB * SEQ;
constexpr int DIN = 5120, DFF = 4096;
constexpr int SBLK = 128;
constexpr float EPS = 1e-6f;
constexpr int NWAVES = 8;

constexpr size_t MiB = 1u << 20;
constexpr size_t WS_WIN = 0;
constexpr size_t WS_WOUT = 10 * MiB;
constexpr size_t WS_WFF1 = 12 * MiB;
constexpr size_t WS_WFF2 = 20 * MiB;
constexpr size_t WS_WPOOL = 28 * MiB;
constexpr size_t WS_WSGU = 28 * MiB + 512 * 1024;
constexpr size_t WS_WSP = 29 * MiB;
constexpr size_t WS_BAR = 30 * MiB;
constexpr size_t WS_R1 = 32 * MiB;
constexpr size_t WS_R2 = 96 * MiB;
constexpr size_t WS_Z = 160 * MiB;
constexpr size_t WS_Y = WS_Z + 256 * MiB;
constexpr size_t WS_PART = 480 * MiB;
constexpr size_t WS_END = 484 * MiB;

constexpr int LDS_BYTES = 147456;
constexpr int VS_STRIDE = 528;
constexpr int MX_VS = 0, MX_PS = 128 * VS_STRIDE, MX_ST = (128 + 143) * VS_STRIDE;

__device__ __forceinline__ unsigned f2bf(float f) { unsigned u = __builtin_bit_cast(unsigned, f); return (u + 0x7fffu + ((u >> 16) & 1u)) >> 16; }
typedef __bf16 bf16x2_t __attribute__((ext_vector_type(2)));
__device__ __forceinline__ unsigned pk2(float lo, float hi) { const f32x2 v = {lo, hi}; const bf16x2_t b = __builtin_convertvector(v, bf16x2_t); return __builtin_bit_cast(unsigned, b); }
__device__ __forceinline__ float bf_lo(unsigned u) { return __builtin_bit_cast(float, u << 16); }
__device__ __forceinline__ float bf_hi(unsigned u) { return __builtin_bit_cast(float, u & 0xffff0000u); }
__device__ __forceinline__ float gelu_tanh(float x) {
    const float t = x * (1.0f + 0.044715f * x * x);
    const float e = __builtin_amdgcn_exp2f(-2.3022081984f * t);
    return x * __builtin_amdgcn_rcpf(1.0f + e);
}
__device__ __forceinline__ f32x4 gelu_tanh4(f32x4 x) {
    const f32x4 t = x * (x * x * 0.044715f + 1.0f), z = t * (-2.3022081984f);
    f32x4 e; e.x = __builtin_amdgcn_exp2f(z.x); e.y = __builtin_amdgcn_exp2f(z.y); e.z = __builtin_amdgcn_exp2f(z.z); e.w = __builtin_amdgcn_exp2f(z.w);
    const f32x4 d = e + 1.0f;
    f32x4 r; r.x = __builtin_amdgcn_rcpf(d.x); r.y = __builtin_amdgcn_rcpf(d.y); r.z = __builtin_amdgcn_rcpf(d.z); r.w = __builtin_amdgcn_rcpf(d.w);
    return x * r;
}
__device__ __forceinline__ f32x4 sigmoid4(f32x4 x) {
    const f32x4 z = x * (-1.4426950409f);
    f32x4 e; e.x = __builtin_amdgcn_exp2f(z.x); e.y = __builtin_amdgcn_exp2f(z.y); e.z = __builtin_amdgcn_exp2f(z.z); e.w = __builtin_amdgcn_exp2f(z.w);
    const f32x4 d = e + 1.0f;
    f32x4 r; r.x = __builtin_amdgcn_rcpf(d.x); r.y = __builtin_amdgcn_rcpf(d.y); r.z = __builtin_amdgcn_rcpf(d.z); r.w = __builtin_amdgcn_rcpf(d.w);
    return r;
}
__device__ __forceinline__ float sigmoidf_(float x) { return __builtin_amdgcn_rcpf(1.0f + __builtin_amdgcn_exp2f(-1.4426950409f * x)); }
__device__ __forceinline__ float wave_sum(float v) {
#pragma unroll
    for (int o = 1; o < 64; o <<= 1) v += __shfl_xor(v, o);
    return v;
}

__host__ __device__ __forceinline__ size_t tm_off(int r, int c8, int K) {
    int ob = (r & 15) * 64 + (c8 & 31) * 2; ob ^= ((ob >> 9) & 1) << 5;
    return ((size_t)(r >> 4) * (K >> 5) + (c8 >> 5)) * 512 + (ob >> 1);
}
namespace pg8 {
constexpr int BM = 256, BK = 64, HALF = 128, HTB = HALF * BK * 2, STAGE_BYTES = 8 * HTB, NXCD = 8, WGM = 8;
__host__ __device__ __forceinline__ int lds_byte(int r, int c) { const int st = (r >> 4) * 2 + (c >> 5), rr = r & 15, cc = c & 31, ob = rr * 64 + cc * 2; return st * 1024 + (ob ^ (((ob >> 9) & 1) << 5)); }
__host__ __device__ __forceinline__ void stage_rc(int b, int& R, int& C) { const int st = b / 1024, sb = b % 1024, swz = sb ^ (((sb >> 9) & 1) << 5); R = (st >> 1) * 16 + swz / 64; C = (st & 1) * 32 + (swz % 64) / 2; }
__host__ __device__ __forceinline__ int perm32(int rho) { const int n = rho >> 4, i = rho & 15; return 8 * (i >> 2) + 4 * n + (i & 3); }

struct Unit { int pm, pn; };
struct Gemm { const bf16_t* A; const bf16_t* Bt; int M, N, K; };

struct StaticOrder {
    int nM, nN, nwg, G, c;
    __host__ __device__ void init(int M_, int N_, int G_, int c_) { nM = M_ / BM; nN = N_ / BM; nwg = nM * nN; G = G_; c = c_; }
    __host__ __device__ bool next(int i, Unit& u) const {
        const long L = (long)i * G + c; if (L >= nwg) return false;
        int wgid = (int)L; { const int q = nwg / NXCD, r = nwg % NXCD, xcd = wgid % NXCD, off = wgid / NXCD; wgid = (xcd < r ? xcd * (q + 1) : r * (q + 1) + (xcd - r) * q) + off; }
        const int nig = WGM * nN, gid = wgid / nig, fm = gid * WGM, gsz = (nM - fm) < WGM ? (nM - fm) : WGM;
        u.pm = fm + ((wgid % nig) % gsz); u.pn = (wgid % nig) / gsz; return true;
    }
    __device__ __forceinline__ void a_ready(const Unit&) const {}
    __device__ __forceinline__ void done(const Unit&) const {}
};

struct EpiF32 {
    static constexpr bool PERM = false, AFTER_DRAIN = false;
    float* C; int ldc;
    __device__ __forceinline__ void operator()(const f32x4 (&acc)[2][2][4][2], const Unit& u, int wr, int wc, int fr, int fq) const {
        const int row0 = u.pm * BM + wr * 64 + fr, col0 = u.pn * BM + wc * 32 + 4 * fq;
#pragma unroll
        for (int ai = 0; ai < 2; ++ai)
#pragma unroll
            for (int m = 0; m < 4; ++m) { float* rowp = C + (size_t)(row0 + ai * HALF + m * 16) * ldc + col0;
#pragma unroll
                for (int bj = 0; bj < 2; ++bj)
#pragma unroll
                    for (int n = 0; n < 2; ++n) *(f32x4*)(rowp + bj * HALF + n * 16) = acc[ai][bj][m][n]; }
    }
};
template <int MODE> struct EpiBf16 {
    static constexpr bool PERM = true, AFTER_DRAIN = false;
    bf16_t* O; int ldc; const float* bias; float* part;
    __device__ __forceinline__ void operator()(const f32x4 (&acc)[2][2][4][2], const Unit& u, int wr, int wc, int fr, int fq) const {
        const int row0 = u.pm * BM + wr * 64 + fr, col0 = u.pn * BM + wc * 32 + 8 * fq;
        const int seg = u.pn >> 2; const int act = (MODE == 0) ? ((seg == 1 || seg == 2) ? 1 : (seg >= 3 ? 2 : 0)) : (MODE == 1 ? 3 : 0);
        const bool tiled = (MODE == 0) && (seg == 1 || seg >= 3);
        const int lane = fq * 16 + fr;
        f32x4 bv[2][2];
#pragma unroll
        for (int bj = 0; bj < 2; ++bj)
#pragma unroll
            for (int n = 0; n < 2; ++n) bv[bj][n] = (MODE == 0) ? *(const f32x4*)(bias + col0 + bj * HALF + 4 * n) : (f32x4){0.f, 0.f, 0.f, 0.f};
#pragma unroll
        for (int ai = 0; ai < 2; ++ai)
#pragma unroll
            for (int m = 0; m < 4; ++m) {
                bf16_t* rowp;
                if (MODE == 0) {
                    bf16_t* plane = O + (size_t)seg * ((size_t)M * 1024);
                    const int cseg = (u.pn & 3) * BM + wc * 32;
                    const int rt = (u.pm * BM + wr * 64 + ai * HALF + m * 16) >> 4;
                    rowp = tiled ? plane + ((size_t)rt * 32 + (cseg >> 5)) * 512 + lane * 8
                                 : plane + (size_t)(row0 + ai * HALF + m * 16) * 1024 + cseg + 8 * fq;
                } else rowp = O + (size_t)(row0 + ai * HALF + m * 16) * ldc + col0;
                f32x4 ls4 = (f32x4){0.f, 0.f, 0.f, 0.f}, lq4 = (f32x4){0.f, 0.f, 0.f, 0.f};
#pragma unroll
                for (int bj = 0; bj < 2; ++bj) { f32x4 v0 = acc[ai][bj][m][0] + bv[bj][0], v1 = acc[ai][bj][m][1] + bv[bj][1];
                    if (act == 1) { v0 = gelu_tanh4(v0); v1 = gelu_tanh4(v1); if (MODE == 0 && seg == 2) { ls4 += v0 + v1; lq4 += v0 * v0 + v1 * v1; } }
                    else if (act == 2) { v0 = sigmoid4(v0); v1 = sigmoid4(v1); }
                    else if (act == 3) { const f32x4 a = __builtin_elementwise_max(v0, (f32x4){0.f, 0.f, 0.f, 0.f}), b = __builtin_elementwise_max(v1, (f32x4){0.f, 0.f, 0.f, 0.f}); v0 = a * a; v1 = b * b; }
                    u32x4 w; w.x = pk2(v0[0], v0[1]); w.y = pk2(v0[2], v0[3]); w.z = pk2(v1[0], v1[1]); w.w = pk2(v1[2], v1[3]);
                    if (MODE == 0) __builtin_nontemporal_store(w, (u32x4*)(rowp + (tiled ? bj * 4 * 512 : bj * HALF)));
                    else if (MODE == 1) __builtin_nontemporal_store(w, (u32x4*)(O + tm_off(row0 + ai * HALF + m * 16, col0 + bj * HALF, ldc)));
                    else *(u32x4*)(rowp + bj * HALF) = w; }
                if (MODE == 0 && seg == 2) {
                    float ls = (ls4.x + ls4.y) + (ls4.z + ls4.w), lq = (lq4.x + lq4.y) + (lq4.z + lq4.w);
                    ls += __shfl_xor(ls, 16); ls += __shfl_xor(ls, 32); lq += __shfl_xor(lq, 16); lq += __shfl_xor(lq, 32);
                    if (fq == 0) *(f32x2*)(part + ((size_t)(row0 + ai * HALF + m * 16) * 16 + (u.pn & 3) * 4 + wc) * 2) = (f32x2){ls, lq};
                } }
    }
};

template <class Epi, class Sched, bool ALIGN_EPI = false, bool SP2 = false>
__device__ __forceinline__ void gemm_phase(LAS unsigned char* lds, const Gemm g, const Sched& S, const Epi& E) {
    int tid_l = threadIdx.x; asm volatile("" : "+v"(tid_l));
    const int tid = tid_l, wid = __builtin_amdgcn_readfirstlane(tid >> 6), lane = tid & 63, wr = wid >> 2, wc = wid & 3, fr = lane & 15, fq = lane >> 4;
    const int K = g.K, nt = K / BK;
    unsigned voffA[2], voffB[2];
#pragma unroll
    for (int i = 0; i < 2; ++i) { const int b = tid * 16 + i * 8192, st = b >> 10;
        voffA[i] = (unsigned)(((st >> 1) * (K >> 5) + (st & 1)) * 1024 + (b & 1023)); voffB[i] = voffA[i]; }
    static_assert(Epi::PERM, "the weight copies are stored row-permuted for PERM epilogues");
    const size_t kstep = (size_t)2048;
    const size_t hstep = (size_t)8 * (K >> 5) * 1024;
    const size_t tstep = 2 * hstep;
    const unsigned ldsw = (unsigned)wid * 1024u;
    const int aoff = lds_byte(wr * 64 + fr, fq * 8), boff = lds_byte(wc * 32 + fr, fq * 8);
#define PG8_SA(b, h) (((b) * 2 + (h)) * HTB)
#define PG8_SB(b, h) ((4 + (b) * 2 + (h)) * HTB)
#define PG8_STAGE(bufoff, gbase, voff) do { _Pragma("unroll") for (int _i = 0; _i < 2; ++_i) \
        __builtin_amdgcn_global_load_lds((const unsigned*)((const char*)(gbase) + (voff)[_i]), (LAS unsigned*)(lds + (bufoff) + ldsw + _i * 8192), 16, 0, 0); } while (0)
#define PG8_LDA(dst, b, h) do { _Pragma("unroll") for (int m = 0; m < 4; ++m) _Pragma("unroll") for (int k = 0; k < 2; ++k) dst[m][k] = *(const LAS bf16x8*)(lds + PG8_SA(b, h) + aoff + m * 2048 + k * 1024); } while (0)
#define PG8_LDB(dst, b, h) do { _Pragma("unroll") for (int n = 0; n < 2; ++n) _Pragma("unroll") for (int k = 0; k < 2; ++k) dst[n][k] = *(const LAS bf16x8*)(lds + PG8_SB(b, h) + boff + n * 2048 + k * 1024); } while (0)
#define PG8_MMA(ai, bj, At, Bt) do { __builtin_amdgcn_s_setprio(1); _Pragma("unroll") for (int m = 0; m < 4; ++m) _Pragma("unroll") for (int n = 0; n < 2; ++n) _Pragma("unroll") for (int k = 0; k < 2; ++k) \
        acc[ai][bj][m][n] = __builtin_amdgcn_mfma_f32_16x16x32_bf16(Bt[n][k], At[m][k], acc[ai][bj][m][n], 0, 0, 0); __builtin_amdgcn_s_setprio(0); } while (0)
#define PG8_WAIT_V(n) asm volatile("s_waitcnt vmcnt(" #n ")" ::: "memory")
#define PG8_WAIT_L(n) asm volatile("s_waitcnt lgkmcnt(" #n ")" ::: "memory")
#define PG8_BAR __builtin_amdgcn_s_barrier()
#define PG8_SCHED __builtin_amdgcn_sched_barrier(0)
    Unit cur, nxt; int ui = 0;
    if (!S.next(0, cur)) return;
    f32x4 acc[2][2][4][2];
#pragma unroll
    for (int a = 0; a < 2; ++a)
#pragma unroll
        for (int b = 0; b < 2; ++b)
#pragma unroll
            for (int m = 0; m < 4; ++m)
#pragma unroll
                for (int n = 0; n < 2; ++n) acc[a][b][m][n] = (f32x4){0.f, 0.f, 0.f, 0.f};
    bf16x8 At[4][2], B0[2][2], B1[2][2];
    const char* cA = (const char*)g.A + (size_t)cur.pm * tstep; const char* cB = (const char*)g.Bt + (size_t)cur.pn * tstep;
    S.a_ready(cur);
    if constexpr (SP2) {
        PG8_STAGE(PG8_SB(0, 0), cB, voffB); PG8_STAGE(PG8_SB(0, 1), cB + hstep, voffB); PG8_STAGE(PG8_SA(0, 0), cA, voffA); PG8_STAGE(PG8_SA(0, 1), cA + hstep, voffA);
        if (wr == 1) PG8_BAR;
        PG8_WAIT_V(2); PG8_BAR;
        PG8_STAGE(PG8_SB(1, 0), cB + kstep, voffB); PG8_STAGE(PG8_SA(1, 0), cA + kstep, voffA); PG8_STAGE(PG8_SB(1, 1), cB + hstep + kstep, voffB);
        PG8_WAIT_V(6); PG8_BAR;
    } else {
        PG8_STAGE(PG8_SB(0, 0), cB, voffB); PG8_STAGE(PG8_SA(0, 0), cA, voffA); PG8_STAGE(PG8_SB(0, 1), cB + hstep, voffB); PG8_STAGE(PG8_SA(0, 1), cA + hstep, voffA);
        if (wr == 1) PG8_BAR;
        PG8_WAIT_V(4); PG8_BAR;
        PG8_STAGE(PG8_SB(1, 0), cB + kstep, voffB); PG8_STAGE(PG8_SA(1, 0), cA + kstep, voffA); PG8_STAGE(PG8_SB(1, 1), cB + hstep + kstep, voffB);
        PG8_WAIT_V(6); PG8_BAR;
    }
    for (;;) {
        const bool has_next = S.next(ui + 1, nxt);
        const char* nA = has_next ? (const char*)g.A + (size_t)nxt.pm * tstep : cA; const char* nB = has_next ? (const char*)g.Bt + (size_t)nxt.pn * tstep : cB;
        for (int t = 0; t < nt; t += 2) {
            const bool last = (t == nt - 2);
            const char* a1 = cA + (size_t)(t + 1) * kstep;
            const char* a2 = last ? nA : cA + (size_t)(t + 2) * kstep; const char* b2 = last ? nB : cB + (size_t)(t + 2) * kstep;
            const char* a3 = a2 + kstep; const char* b3 = b2 + kstep;
            if (last && has_next) S.a_ready(nxt);
            if constexpr (SP2) {
            PG8_LDB(B0, 0, 0); PG8_LDB(B1, 0, 1); PG8_SCHED; PG8_LDA(At, 0, 0); PG8_STAGE(PG8_SA(1, 1), a1 + hstep, voffA);
            PG8_WAIT_V(8); PG8_WAIT_L(0); PG8_BAR; PG8_MMA(0, 0, At, B0); PG8_MMA(0, 1, At, B1); PG8_BAR; PG8_SCHED;
            PG8_LDA(At, 0, 1); PG8_STAGE(PG8_SB(0, 0), b2, voffB); PG8_STAGE(PG8_SB(0, 1), b2 + hstep, voffB); PG8_STAGE(PG8_SA(0, 0), a2, voffA);
            PG8_WAIT_V(8); PG8_WAIT_L(0); PG8_BAR; PG8_MMA(1, 0, At, B0); PG8_MMA(1, 1, At, B1); PG8_BAR; PG8_SCHED;
            PG8_LDB(B0, 1, 0); PG8_LDB(B1, 1, 1); PG8_SCHED; PG8_LDA(At, 1, 0); PG8_STAGE(PG8_SA(0, 1), a2 + hstep, voffA);
            PG8_WAIT_V(8); PG8_WAIT_L(0); PG8_BAR; PG8_MMA(0, 0, At, B0); PG8_MMA(0, 1, At, B1); PG8_BAR; PG8_SCHED;
            PG8_LDA(At, 1, 1); PG8_STAGE(PG8_SB(1, 0), b3, voffB); PG8_STAGE(PG8_SB(1, 1), b3 + hstep, voffB); PG8_STAGE(PG8_SA(1, 0), a3, voffA);
            PG8_WAIT_V(8); PG8_WAIT_L(0); PG8_BAR; PG8_MMA(1, 0, At, B0); PG8_MMA(1, 1, At, B1); PG8_BAR; PG8_SCHED;
            } else {
            PG8_LDB(B0, 0, 0); PG8_SCHED; PG8_LDA(At, 0, 0); PG8_STAGE(PG8_SA(1, 1), a1 + hstep, voffA);
            PG8_WAIT_L(8); PG8_BAR; PG8_WAIT_L(0); PG8_MMA(0, 0, At, B0); PG8_BAR; PG8_SCHED;
            PG8_LDB(B1, 0, 1); PG8_STAGE(PG8_SB(0, 0), b2, voffB);
            PG8_BAR; PG8_WAIT_L(0); PG8_MMA(0, 1, At, B1); PG8_BAR;
            PG8_LDA(At, 0, 1); PG8_STAGE(PG8_SA(0, 0), a2, voffA);
            PG8_BAR; PG8_WAIT_L(0); PG8_MMA(1, 0, At, B0); PG8_BAR; PG8_SCHED;
            PG8_STAGE(PG8_SB(0, 1), b2 + hstep, voffB);
            PG8_WAIT_V(6); PG8_BAR; PG8_MMA(1, 1, At, B1); PG8_BAR;
            PG8_LDB(B0, 1, 0); PG8_SCHED; PG8_LDA(At, 1, 0); PG8_STAGE(PG8_SA(0, 1), a2 + hstep, voffA);
            PG8_WAIT_L(8); PG8_BAR; PG8_WAIT_L(0); PG8_MMA(0, 0, At, B0); PG8_BAR; PG8_SCHED;
            PG8_LDB(B1, 1, 1); PG8_STAGE(PG8_SB(1, 0), b3, voffB);
            PG8_BAR; PG8_WAIT_L(0); PG8_MMA(0, 1, At, B1); PG8_BAR;
            PG8_LDA(At, 1, 1); PG8_STAGE(PG8_SA(1, 0), a3, voffA);
            PG8_BAR; PG8_WAIT_L(0); PG8_MMA(1, 0, At, B0); PG8_BAR; PG8_SCHED;
            PG8_STAGE(PG8_SB(1, 1), b3 + hstep, voffB);
            PG8_WAIT_V(6); PG8_BAR; PG8_MMA(1, 1, At, B1); PG8_BAR;
            }
        }
        if constexpr (ALIGN_EPI) { if (wr == 0) PG8_BAR; }
        if constexpr (!Epi::AFTER_DRAIN) { E(acc, cur, wr, wc, fr, fq); S.done(cur); }
        if (!has_next) break;
#pragma unroll
        for (int a = 0; a < 2; ++a)
#pragma unroll
            for (int b = 0; b < 2; ++b)
#pragma unroll
                for (int m = 0; m < 4; ++m)
#pragma unroll
                    for (int n = 0; n < 2; ++n) acc[a][b][m][n] = (f32x4){0.f, 0.f, 0.f, 0.f};
        cur = nxt; cA = nA; cB = nB; ++ui;
        if constexpr (ALIGN_EPI) { if (wr == 1) PG8_BAR; }
    }
    PG8_WAIT_V(0);
    if constexpr (!ALIGN_EPI) { if (wr == 0) PG8_BAR; }
    PG8_BAR;
#undef PG8_SA
#undef PG8_SB
#undef PG8_STAGE
#undef PG8_LDA
#undef PG8_LDB
#undef PG8_MMA
#undef PG8_WAIT_V
#undef PG8_WAIT_L
#undef PG8_BAR
#undef PG8_SCHED
}
}

struct Args {
    const float* x; const float* n1pre; const float* w_in; const float* b_in; const float* w_pool; const float* pool_scale;
    const float* ln_g; const float* ln_b; const float* w_sp; const float* b_sp; const float* w_sgu; const float* w_out;
    const float* n1post; const float* n2pre; const float* w_ff1; const float* w_ff2; const float* n2post;
    float* out; unsigned char* ws;
};

template <bool TILED = false>
__device__ __forceinline__ void p0_transpose_item(const float* W, int K, int N, bf16_t* WT, LAS float* scr, int item, int lane) {
    const int nblk = N / 32, kb = item / nblk, nb = item % nblk, k0 = 64 * kb, n0 = 32 * nb;
    float wv[32];
#pragma unroll
    for (int i = 0; i < 32; ++i) wv[i] = __builtin_nontemporal_load(W + (size_t)(k0 + 2 * i + (lane >> 5)) * N + n0 + (lane & 31));
#pragma unroll
    for (int i = 0; i < 32; ++i) scr[(2 * i + (lane >> 5)) * 33 + (lane & 31)] = wv[i];
    asm volatile("s_waitcnt lgkmcnt(0)" ::: "memory");
    const int c = lane & 7;
#pragma unroll
    for (int j = 0; j < 4; ++j) { const int n = (lane >> 3) + 8 * j; const LAS float* s = scr + (8 * c) * 33 + n;
        u32x4 o; o.x = pk2(s[0 * 33], s[1 * 33]); o.y = pk2(s[2 * 33], s[3 * 33]); o.z = pk2(s[4 * 33], s[5 * 33]); o.w = pk2(s[6 * 33], s[7 * 33]);
        if (TILED) { const int d = n0 + n, kc = (k0 >> 3) + c, T = (d >> 5) * 2 + ((d >> 2) & 1), fr = (((d & 31) >> 3) << 2) | (d & 3);
            *(u32x4*)(WT + ((size_t)(T * (K >> 5) + (kc >> 2)) * 64 + (kc & 3) * 16 + fr) * 8) = o; }
        else { const int nn = n0 + n, x = nn & 31, Rr = (nn & ~31) + 16 * ((x >> 2) & 1) + 4 * (x >> 3) + (x & 3);
            *(u32x4*)(WT + tm_off(Rr, k0 + 8 * c, K)) = o; } }
    asm volatile("s_waitcnt lgkmcnt(0)" ::: "memory");
}
__device__ __forceinline__ void p0_prologue(const Args& a, LAS unsigned char* lds, int wave, int lane) {
    LAS float* scr = (LAS float*)(lds + wave * 16384);
    const int gw = blockIdx.x * NWAVES + wave, NGW = gridDim.x * NWAVES;
    constexpr int I_IN = (DM / 64) * (DIN / 32), I_OUT = (DM / 64) * (DM / 32), I_F1 = (DM / 64) * (DFF / 32), I_F2 = (DFF / 64) * (DM / 32), I_G = (256 / 64) * (256 / 32);
    constexpr int NITEMS = I_IN + I_OUT + I_F1 + I_F2 + 8 * I_G;
    unsigned char* ws = a.ws;
    for (int it = gw; it < NITEMS; it += NGW) {
        int r = it;
        if (r < I_IN) { p0_transpose_item(a.w_in, DM, DIN, (bf16_t*)(ws + WS_WIN), scr, r, lane); continue; } r -= I_IN;
        if (r < I_OUT) { p0_transpose_item(a.w_out, DM, DM, (bf16_t*)(ws + WS_WOUT), scr, r, lane); continue; } r -= I_OUT;
        if (r < I_F1) { p0_transpose_item(a.w_ff1, DM, DFF, (bf16_t*)(ws + WS_WFF1), scr, r, lane); continue; } r -= I_F1;
        if (r < I_F2) { p0_transpose_item(a.w_ff2, DFF, DM, (bf16_t*)(ws + WS_WFF2), scr, r, lane); continue; } r -= I_F2;
        const int gsel = r / I_G, ri = r % I_G;
        if (gsel < 4) p0_transpose_item<true>(a.w_pool + (size_t)gsel * 65536, 256, 256, (bf16_t*)(ws + WS_WPOOL) + (size_t)gsel * 65536, scr, ri, lane);
        else p0_transpose_item<true>(a.w_sgu + (size_t)(gsel - 4) * 65536, 256, 256, (bf16_t*)(ws + WS_WSGU) + (size_t)(gsel - 4) * 65536, scr, ri, lane);
    }
    { unsigned* bw = (unsigned*)(ws + WS_BAR); for (int e = blockIdx.x * 512 + threadIdx.x; e < 3456; e += gridDim.x * 512) bw[e] = 0u; }
    { bf16_t* wsp = (bf16_t*)(ws + WS_WSP);
      for (int e = (blockIdx.x * 512 + threadIdx.x); e < 4 * 128 * 128; e += gridDim.x * 512) { const int i = (e >> 7) & 127, j = e & 127; const float v = ((i >> 6) >= (j >> 6)) ? a.w_sp[e] : 0.f;
          wsp[((size_t)(((e >> 14) * 8 + (i >> 4)) * 4 + (j >> 5)) * 64 + ((j >> 3) & 3) * 16 + (i & 15)) * 8 + (j & 7)] = (bf16_t)f2bf(v); } }
    bf16_t* XN = (bf16_t*)(ws + WS_R1);
    f32x4 gv[4];
#pragma unroll
    for (int j = 0; j < 2; ++j) { gv[2 * j] = *(const f32x4*)(a.n1pre + 512 * j + 8 * lane); gv[2 * j + 1] = *(const f32x4*)(a.n1pre + 512 * j + 8 * lane + 4); }
    for (int m0 = gw * 2; m0 < M; m0 += NGW * 2) {
        f32x4 v[2][4];
#pragma unroll
        for (int r = 0; r < 2; ++r) { const float* xr = a.x + (size_t)(m0 + r) * DM + 8 * lane;
            v[r][0] = __builtin_nontemporal_load((const f32x4*)(xr)); v[r][1] = __builtin_nontemporal_load((const f32x4*)(xr + 4)); v[r][2] = __builtin_nontemporal_load((const f32x4*)(xr + 512)); v[r][3] = __builtin_nontemporal_load((const f32x4*)(xr + 516)); }
#pragma unroll
        for (int r = 0; r < 2; ++r) {
            float s = 0.f;
#pragma unroll
            for (int j = 0; j < 4; ++j) s += (v[r][j].x * v[r][j].x + v[r][j].y * v[r][j].y) + (v[r][j].z * v[r][j].z + v[r][j].w * v[r][j].w);
            const float rstd = 1.0f / sqrtf(wave_sum(s) * (1.f / DM) + EPS);
#pragma unroll
            for (int j = 0; j < 2; ++j) { const f32x4 t0 = v[r][2 * j] * rstd * gv[2 * j], t1 = v[r][2 * j + 1] * rstd * gv[2 * j + 1];
                u32x4 w; w.x = pk2(t0.x, t0.y); w.y = pk2(t0.z, t0.w); w.z = pk2(t1.x, t1.y); w.w = pk2(t1.z, t1.w); *(u32x4*)(XN + tm_off(m0 + r, 512 * j + 8 * lane, DM)) = w; }
        }
    }
}

template <int W>
__device__ __forceinline__ void pool_tile(int pos0, LAS unsigned char* Ps, int tid) {
    const int c4 = (tid & 63) * 4, r0 = (tid >> 6) * 16;
    const LAS unsigned char* src = Ps + (r0 + 15 - (W - 1)) * VS_STRIDE + c4 * 2;
    u32x2 hist[W - 1 + 16];
#pragma unroll
    for (int s = 0; s < W - 1 + 16; ++s) hist[s] = *(const LAS u32x2*)(src + s * VS_STRIDE);
    __syncthreads();
    float S0 = 0.f, S1 = 0.f, S2 = 0.f, S3 = 0.f;
#pragma unroll
    for (int s = 0; s < W - 1; ++s) { const u32x2 v = hist[s]; S0 += bf_lo(v.x); S1 += bf_hi(v.x); S2 += bf_lo(v.y); S3 += bf_hi(v.y); }
#pragma unroll
    for (int t = 0; t < 16; ++t) {
        const u32x2 v = hist[W - 1 + t];
        const float p0 = bf_lo(v.x), p1 = bf_hi(v.x), p2 = bf_lo(v.y), p3 = bf_hi(v.y);
        S0 += p0; S1 += p1; S2 += p2; S3 += p3;
        const int pos = pos0 + r0 + t; const float inv = (pos + 1 < W) ? __builtin_amdgcn_rcpf((float)(pos + 1)) : (1.0f / W);
        u32x2 o; o.x = pk2(S0 * inv - p0, S1 * inv - p1); o.y = pk2(S2 * inv - p2, S3 * inv - p3);
        *(LAS u32x2*)(Ps + (r0 + t) * VS_STRIDE + c4 * 2) = o;
        const u32x2 old = hist[t];
        S0 -= bf_lo(old.x); S1 -= bf_hi(old.x); S2 -= bf_lo(old.y); S3 -= bf_hi(old.y);
    }
}

__device__ __forceinline__ void mixer_phase(const Args& a, LAS unsigned char* lds, int tid_, int wave, int lane_) {
    const bf16_t* Z = (const bf16_t*)(a.ws + WS_Z);
    const bf16_t* ZU = Z + (size_t)M * 1024; const bf16_t* ZV = Z + 2 * (size_t)M * 1024; const bf16_t* ZGA = Z + 3 * (size_t)M * 1024; const bf16_t* ZGB = Z + 4 * (size_t)M * 1024;
    bf16_t* MG = (bf16_t*)(a.ws + WS_R2);
    const bf16_t* Wsp = (const bf16_t*)(a.ws + WS_WSP);
    const bf16_t* Wpool = (const bf16_t*)(a.ws + WS_WPOOL);
    const bf16_t* Wsgu = (const bf16_t*)(a.ws + WS_WSGU);
    LAS unsigned char* Vs = lds + MX_VS; LAS unsigned char* Ps = lds + MX_PS; LAS f32x2* ST = (LAS f32x2*)(lds + MX_ST);
    const int wr = wave >> 2, wc = wave & 3;
    for (int unit = blockIdx.x; unit < M / SBLK; unit += gridDim.x) {
        const int tok0 = unit * SBLK, pos0_ = tok0 % SEQ; const int lane = lane_;
        if (tid_ < 128) {
            const f32x4* pp = (const f32x4*)((const float*)(a.ws + WS_PART) + (size_t)(tok0 + tid_) * 32);
            float sm = 0.f, q = 0.f;
#pragma unroll
            for (int k = 0; k < 8; ++k) { const f32x4 t = pp[k]; sm += t.x + t.z; q += t.y + t.w; }
            const float mean = sm * (1.f / 1024.f), var = fmaxf(q * (1.f / 1024.f) - mean * mean, 0.f);
            ST[tid_] = (f32x2){mean, 1.0f / sqrtf(var + EPS)};
        }
        __syncthreads();
#pragma unroll 1
        for (int h = 0; h < 4; ++h) {
            int tid = tid_, pos0 = pos0_;
            asm volatile("" : "+v"(tid)); asm volatile("" : "+s"(pos0));
            const int lane = tid & 63, fr = lane & 15, fq = lane >> 4;
            {
                const int ch = (tid & 31) * 8, rg = (tid >> 5) * 8;
                u32x4 pr[9], vv[8];
#pragma unroll
                for (int rr = 0; rr < 8; ++rr) vv[rr] = __builtin_nontemporal_load((const u32x4*)(ZV + (size_t)(tok0 + rg + rr) * 1024 + h * 256 + ch));
#pragma unroll
                for (int k = 0; k < 9; ++k) {
                    int rr = (tid + k * 512) >> 5; rr = rr > 142 ? 142 : rr;
                    int grow = tok0 + rr - 15; grow = grow < 0 ? 0 : grow;
                    pr[k] = __builtin_nontemporal_load((const u32x4*)(Z + (size_t)grow * 1024 + h * 256 + ch));
                }
                const f32x4 g0 = *(const f32x4*)(a.ln_g + h * 256 + ch), g1 = *(const f32x4*)(a.ln_g + h * 256 + ch + 4);
                const f32x4 b0 = *(const f32x4*)(a.ln_b + h * 256 + ch), b1 = *(const f32x4*)(a.ln_b + h * 256 + ch + 4);
#pragma unroll
                for (int k = 0; k < 9; ++k) {
                    const int idx = tid + k * 512, rr = idx >> 5;
                    if (idx < 143 * 32) { const u32x4 v = (pos0 + rr - 15 >= 0) ? pr[k] : (u32x4){0u, 0u, 0u, 0u}; *(LAS u32x4*)(Ps + rr * VS_STRIDE + ch * 2) = v; }
                }
#pragma unroll
                for (int rr = 0; rr < 8; ++rr) {
                    const int r = rg + rr; const f32x2 st = ST[r]; const u32x4 v = vv[rr];
                    f32x4 lo = (f32x4){bf_lo(v.x), bf_hi(v.x), bf_lo(v.y), bf_hi(v.y)}, hi = (f32x4){bf_lo(v.z), bf_hi(v.z), bf_lo(v.w), bf_hi(v.w)};
                    lo = (lo - st.x) * st.y * g0 + b0; hi = (hi - st.x) * st.y * g1 + b1;
                    u32x4 o; o.x = pk2(lo.x, lo.y); o.y = pk2(lo.z, lo.w); o.z = pk2(hi.x, hi.y); o.w = pk2(hi.z, hi.w);
                    *(LAS u32x4*)(Vs + r * VS_STRIDE + ch * 2) = o;
                }
            }
            __syncthreads();
            if (h == 0) pool_tile<2>(pos0, Ps, tid);
            else if (h == 1) pool_tile<4>(pos0, Ps, tid);
            else if (h == 2) pool_tile<8>(pos0, Ps, tid);
            else pool_tile<16>(pos0, Ps, tid);
            __syncthreads();
            f32x4 acc[4][4];
            u32x4 uu[4][2];
            float bs[4];
#pragma unroll
            for (int x = 0; x < 4; ++x)
#pragma unroll
                for (int y = 0; y < 4; ++y) acc[x][y] = (f32x4){0.f, 0.f, 0.f, 0.f};
            {
                const int li = lane & 15, q = li >> 2, p = li & 3;
                const int nks = (wr == 0) ? 2 : 4;
                bf16x8 wq[4][4];
                const bf16_t* wb = Wsp + ((size_t)(h * 8 + wr * 4) * 4 * 64 + lane) * 8;
#pragma unroll
                for (int ks = 0; ks < 4; ++ks)
                    if (ks < nks) {
#pragma unroll
                        for (int it = 0; it < 4; ++it) wq[ks][it] = *(const bf16x8*)(wb + (it * 4 + ks) * 512);
                    }
#pragma unroll
                for (int it = 0; it < 4; ++it) {
                    const int i = wr * 64 + it * 16 + fr; bs[it] = a.b_sp[h * 128 + i];
                    const bf16_t* ur = ZU + ((size_t)((tok0 + wr * 64 + it * 16) >> 4) * 32 + h * 8 + wc * 2) * 512 + lane * 8;
#pragma unroll
                    for (int cp = 0; cp < 2; ++cp) uu[it][cp] = __builtin_nontemporal_load((const u32x4*)(ur + cp * 512));
                }
#pragma unroll
                for (int ks = 0; ks < 4; ++ks)
                    if (ks < nks) {
                        bf16x8 pv[4];
#pragma unroll
                        for (int ct = 0; ct < 4; ++ct) {
                            const LAS unsigned char* ad = Vs + (ks * 32 + 8 * fq + q) * VS_STRIDE + (wc * 64 + (ct >> 1) * 32 + 8 * p + 4 * (ct & 1)) * 2;
                            const s16x4 t0 = __builtin_bit_cast(s16x4, __builtin_amdgcn_ds_read_tr16_b64_v4i16((LAS s16x4*)ad));
                            const s16x4 t1 = __builtin_bit_cast(s16x4, __builtin_amdgcn_ds_read_tr16_b64_v4i16((LAS s16x4*)(ad + 4 * VS_STRIDE)));
                            pv[ct] = (bf16x8){t0[0], t0[1], t0[2], t0[3], t1[0], t1[1], t1[2], t1[3]};
                        }
#pragma unroll
                        for (int ct = 0; ct < 4; ++ct)
#pragma unroll
                            for (int it = 0; it < 4; ++it) acc[ct][it] = __builtin_amdgcn_mfma_f32_16x16x32_bf16(pv[ct], wq[ks][it], acc[ct][it], 0, 0, 0);
                    }
            }
            __syncthreads();
#pragma unroll
            for (int it = 0; it < 4; ++it) {
                const int i = wr * 64 + it * 16 + fr; const float b = bs[it];
#pragma unroll
                for (int cp = 0; cp < 2; ++cp) {
                    const int c = wc * 64 + cp * 32 + 8 * fq;
                    const u32x4 u4 = uu[it][cp]; const f32x4 s0 = acc[2 * cp][it], s1 = acc[2 * cp + 1][it];
                    u32x4 o; o.x = pk2(bf_lo(u4.x) * (s0[0] + b), bf_hi(u4.x) * (s0[1] + b)); o.y = pk2(bf_lo(u4.y) * (s0[2] + b), bf_hi(u4.y) * (s0[3] + b));
                    o.z = pk2(bf_lo(u4.z) * (s1[0] + b), bf_hi(u4.z) * (s1[1] + b)); o.w = pk2(bf_lo(u4.w) * (s1[2] + b), bf_hi(u4.w) * (s1[3] + b));
                    *(LAS u32x4*)(Vs + i * VS_STRIDE + c * 2) = o;
                }
            }
            __syncthreads();
#pragma unroll 1
            for (int dh = 0; dh < 2; ++dh) {
                f32x4 aca[2][4], acb[2][4];
                u32x4 ga[4], gb[4];
#pragma unroll
                for (int x = 0; x < 2; ++x)
#pragma unroll
                    for (int y = 0; y < 4; ++y) { aca[x][y] = (f32x4){0.f, 0.f, 0.f, 0.f}; acb[x][y] = (f32x4){0.f, 0.f, 0.f, 0.f}; }
                const size_t wtoff = ((size_t)(h * 16 + (wc * 2 + dh) * 2) * 8 * 64 + lane) * 8;
                const bf16_t* wpb = Wpool + wtoff;
                const bf16_t* wgb = Wsgu + wtoff;
                const int qoff = (wr * 64 + fr) * VS_STRIDE + fq * 16;
                const int d0 = h * 256 + wc * 64 + dh * 32 + 8 * fq;
                bf16x8 w[2][8];
#pragma unroll
                for (int dt = 0; dt < 2; ++dt)
#pragma unroll
                    for (int ks = 0; ks < 8; ++ks) w[dt][ks] = *(const bf16x8*)(wpb + (dt * 8 + ks) * 512);
#pragma unroll
                for (int it = 0; it < 4; ++it) {
                    const size_t toff = ((size_t)((tok0 + wr * 64 + it * 16) >> 4) * 32 + h * 8 + wc * 2 + dh) * 512 + lane * 8;
                    ga[it] = __builtin_nontemporal_load((const u32x4*)(ZGA + toff)); gb[it] = __builtin_nontemporal_load((const u32x4*)(ZGB + toff));
                }
#pragma unroll
                for (int ks = 0; ks < 8; ++ks) {
                    bf16x8 qa[4];
#pragma unroll
                    for (int it = 0; it < 4; ++it) qa[it] = *(const LAS bf16x8*)(Ps + qoff + it * 16 * VS_STRIDE + ks * 64);
#pragma unroll
                    for (int dt = 0; dt < 2; ++dt)
#pragma unroll
                        for (int it = 0; it < 4; ++it) aca[dt][it] = __builtin_amdgcn_mfma_f32_16x16x32_bf16(w[dt][ks], qa[it], aca[dt][it], 0, 0, 0);
                }
                { const bf16_t* wgl = wgb; asm volatile("" : "+v"(wgl));
#pragma unroll
                for (int dt = 0; dt < 2; ++dt)
#pragma unroll
                    for (int ks = 0; ks < 8; ++ks) w[dt][ks] = *(const bf16x8*)(wgl + (dt * 8 + ks) * 512); }
#pragma unroll
                for (int ks = 0; ks < 8; ++ks) {
                    bf16x8 qb[4];
#pragma unroll
                    for (int it = 0; it < 4; ++it) qb[it] = *(const LAS bf16x8*)(Vs + qoff + it * 16 * VS_STRIDE + ks * 64);
#pragma unroll
                    for (int dt = 0; dt < 2; ++dt)
#pragma unroll
                        for (int it = 0; it < 4; ++it) acb[dt][it] = __builtin_amdgcn_mfma_f32_16x16x32_bf16(w[dt][ks], qb[it], acb[dt][it], 0, 0, 0);
                }
                {
                    const f32x4 ps0 = *(const f32x4*)(a.pool_scale + d0), ps1 = *(const f32x4*)(a.pool_scale + d0 + 4);
#pragma unroll
                    for (int it = 0; it < 4; ++it) {
                        const int i = wr * 64 + it * 16 + fr;
                        const u32x4 g1 = ga[it], g2 = gb[it];
                        const f32x4 A0 = aca[0][it], B0 = acb[0][it], A1 = aca[1][it], B1 = acb[1][it];
                        u32x4 o;
                        o.x = pk2(bf_lo(g1.x) * ps0[0] * A0[0] + bf_lo(g2.x) * B0[0], bf_hi(g1.x) * ps0[1] * A0[1] + bf_hi(g2.x) * B0[1]);
                        o.y = pk2(bf_lo(g1.y) * ps0[2] * A0[2] + bf_lo(g2.y) * B0[2], bf_hi(g1.y) * ps0[3] * A0[3] + bf_hi(g2.y) * B0[3]);
                        o.z = pk2(bf_lo(g1.z) * ps1[0] * A1[0] + bf_lo(g2.z) * B1[0], bf_hi(g1.z) * ps1[1] * A1[1] + bf_hi(g2.z) * B1[1]);
                        o.w = pk2(bf_lo(g1.w) * ps1[2] * A1[2] + bf_lo(g2.w) * B1[2], bf_hi(g1.w) * ps1[3] * A1[3] + bf_hi(g2.w) * B1[3]);
                        *(u32x4*)(MG + tm_off(tok0 + i, d0, DM)) = o;
                    }
                }
            }
            __syncthreads();
        }
    }
}

__device__ __forceinline__ void unpack8(const u32x4 v, f32x4& lo, f32x4& hi) { lo = (f32x4){bf_lo(v.x), bf_hi(v.x), bf_lo(v.y), bf_hi(v.y)}; hi = (f32x4){bf_lo(v.z), bf_hi(v.z), bf_lo(v.w), bf_hi(v.w)}; }
__device__ __forceinline__ float ssq4(const f32x4 v) { return (v.x * v.x + v.y * v.y) + (v.z * v.z + v.w * v.w); }
__device__ __forceinline__ void rows_mid(const Args& a, int wave, int lane) {
    const bf16_t* Y = (const bf16_t*)(a.ws + WS_Y); bf16_t* HN = (bf16_t*)(a.ws + WS_R1);
    const int gw = blockIdx.x * NWAVES + wave, NGW = gridDim.x * NWAVES;
    f32x4 g1[4], g2[4];
#pragma unroll
    for (int j = 0; j < 2; ++j) { const int c = 512 * j + 8 * lane;
        g1[2 * j] = *(const f32x4*)(a.n1post + c); g1[2 * j + 1] = *(const f32x4*)(a.n1post + c + 4); g2[2 * j] = *(const f32x4*)(a.n2pre + c); g2[2 * j + 1] = *(const f32x4*)(a.n2pre + c + 4); }
    for (int m0 = gw * 2; m0 < M; m0 += NGW * 2) {
        u32x4 yb[2][2]; f32x4 xx[2][4];
#pragma unroll
        for (int r = 0; r < 2; ++r) { const u32x4* yr = (const u32x4*)(Y + (size_t)(m0 + r) * DM) + lane; const float* xr = a.x + (size_t)(m0 + r) * DM + 8 * lane;
            yb[r][0] = __builtin_nontemporal_load(yr); yb[r][1] = __builtin_nontemporal_load(yr + 64);
            xx[r][0] = __builtin_nontemporal_load((const f32x4*)(xr)); xx[r][1] = __builtin_nontemporal_load((const f32x4*)(xr + 4)); xx[r][2] = __builtin_nontemporal_load((const f32x4*)(xr + 512)); xx[r][3] = __builtin_nontemporal_load((const f32x4*)(xr + 516)); }
#pragma unroll
        for (int r = 0; r < 2; ++r) {
            f32x4 y[4]; float s = 0.f;
            unpack8(yb[r][0], y[0], y[1]); unpack8(yb[r][1], y[2], y[3]);
#pragma unroll
            for (int j = 0; j < 4; ++j) s += ssq4(y[j]);
            const float rstd = 1.0f / sqrtf(wave_sum(s) * (1.f / DM) + EPS);
            float s2 = 0.f;
#pragma unroll
            for (int j = 0; j < 4; ++j) { xx[r][j] = xx[r][j] + y[j] * rstd * g1[j]; s2 += ssq4(xx[r][j]); }
            const float rstd2 = 1.0f / sqrtf(wave_sum(s2) * (1.f / DM) + EPS);
            u32x4* oh = (u32x4*)(a.ws + WS_Y) + (size_t)(m0 + r) * (DM / 8) + lane;
#pragma unroll
            for (int j = 0; j < 2; ++j) { const f32x4 t0 = xx[r][2 * j], t1 = xx[r][2 * j + 1];
                u32x4 w; w.x = pk2(t0.x, t0.y); w.y = pk2(t0.z, t0.w); w.z = pk2(t1.x, t1.y); w.w = pk2(t1.z, t1.w); __builtin_nontemporal_store(w, oh + 64 * j); }
#pragma unroll
            for (int j = 0; j < 2; ++j) { const f32x4 t0 = xx[r][2 * j] * rstd2 * g2[2 * j], t1 = xx[r][2 * j + 1] * rstd2 * g2[2 * j + 1];
                u32x4 w; w.x = pk2(t0.x, t0.y); w.y = pk2(t0.z, t0.w); w.z = pk2(t1.x, t1.y); w.w = pk2(t1.z, t1.w); *(u32x4*)(HN + tm_off(m0 + r, 512 * j + 8 * lane, DM)) = w; }
        }
    }
}
__device__ __forceinline__ void rows_final(const Args& a, int wave, int lane) {
    const bf16_t* H1 = (const bf16_t*)(a.ws + WS_Y); const bf16_t* F2 = (const bf16_t*)(a.ws + WS_R2);
    const int gw = blockIdx.x * NWAVES + wave, NGW = gridDim.x * NWAVES;
    f32x4 g2[4];
#pragma unroll
    for (int j = 0; j < 2; ++j) { const int c = 512 * j + 8 * lane; g2[2 * j] = *(const f32x4*)(a.n2post + c); g2[2 * j + 1] = *(const f32x4*)(a.n2post + c + 4); }
    for (int m0 = gw * 2; m0 < M; m0 += NGW * 2) {
        u32x4 hb[2][2], fb[2][2];
#pragma unroll
        for (int r = 0; r < 2; ++r) { const u32x4* hr = (const u32x4*)(H1 + (size_t)(m0 + r) * DM) + lane; const u32x4* fr_ = (const u32x4*)(F2 + (size_t)(m0 + r) * DM) + lane;
            hb[r][0] = __builtin_nontemporal_load(hr); hb[r][1] = __builtin_nontemporal_load(hr + 64); fb[r][0] = __builtin_nontemporal_load(fr_); fb[r][1] = __builtin_nontemporal_load(fr_ + 64); }
#pragma unroll
        for (int r = 0; r < 2; ++r) {
            f32x4 h[4], f[4]; float q = 0.f;
            unpack8(hb[r][0], h[0], h[1]); unpack8(hb[r][1], h[2], h[3]); unpack8(fb[r][0], f[0], f[1]); unpack8(fb[r][1], f[2], f[3]);
#pragma unroll
            for (int j = 0; j < 4; ++j) q += ssq4(f[j]);
            const float rq = 1.0f / sqrtf(wave_sum(q) * (1.f / DM) + EPS);
            float* orow = a.out + (size_t)(m0 + r) * DM + 8 * lane;
#pragma unroll
            for (int j = 0; j < 4; ++j) h[j] = h[j] + f[j] * rq * g2[j];
            __builtin_nontemporal_store(h[0], (f32x4*)(orow)); __builtin_nontemporal_store(h[1], (f32x4*)(orow + 4)); __builtin_nontemporal_store(h[2], (f32x4*)(orow + 512)); __builtin_nontemporal_store(h[3], (f32x4*)(orow + 516));
        }
    }
}

#define XB_TMO      128
#define XB_XCNT(j)  (256  + 64 * (j))
#define XB_XSUB(j)  (1280 + 64 * (j))
#define XB_XGEN(j)  (2304 + 64 * (j))
#define XB_TOP      3328
#define XB_TOPGEN   3392
#define XCD_BAR_WORDS 3456
#define XB_SPIN_CAP (1u << 18)
__device__ __forceinline__ unsigned xb_ld(unsigned* p)              { return __hip_atomic_load(p, __ATOMIC_RELAXED, __HIP_MEMORY_SCOPE_AGENT); }
__device__ __forceinline__ unsigned xb_add(unsigned* p, unsigned v) { return __hip_atomic_fetch_add(p, v, __ATOMIC_RELAXED, __HIP_MEMORY_SCOPE_AGENT); }
__device__ __forceinline__ unsigned xb_xcc_id() { return (unsigned)__builtin_amdgcn_s_getreg((3 << 11) | 20) & 0xFu; }
#define XB_SPIN(cond, bar) do { unsigned _sp = 0; while (cond) { __builtin_amdgcn_s_sleep(1); \
    if ((++_sp & 255u) == 0u) { if (xb_ld(&(bar)[XB_TMO])) break; if (_sp > XB_SPIN_CAP) { atomicAdd(&(bar)[XB_TMO], 1u); break; } } } } while (0)
struct XcdBarrier { unsigned* bar; unsigned x; volatile LAS unsigned* st; };
__device__ __forceinline__ XcdBarrier xcd_barrier_post(unsigned* bar, volatile LAS unsigned* st) {
    XcdBarrier b; b.bar = bar; b.x = xb_xcc_id(); b.st = st;
    if (threadIdx.x == 0) (void)xb_add(&bar[XB_XCNT(b.x)], 1u);
    return b;
}
__device__ __forceinline__ void xcd_barrier_complete(unsigned* bar, unsigned x, unsigned& nloc, unsigned& nx) {
    const unsigned G = gridDim.x * gridDim.y * gridDim.z;
    unsigned sum, cnt, mine, sp = 0u;
    for (;;) {
        sum = 0u; cnt = 0u; mine = 0u;
#pragma unroll
        for (unsigned j = 0; j < 16; ++j) { const unsigned c = xb_ld(&bar[XB_XCNT(j)]); sum += c; cnt += (c > 0u) ? 1u : 0u; mine = (j == x) ? c : mine; }
        if (sum == G) break;
        __builtin_amdgcn_s_sleep(1);
        if ((++sp & 255u) == 0u) { if (xb_ld(&bar[XB_TMO])) break; if (sp > XB_SPIN_CAP) { atomicAdd(&bar[XB_TMO], 1u); break; } }
    }
    nloc = mine > 0u ? mine : 1u; nx = cnt > 0u ? cnt : 1u;
}
__device__ __forceinline__ void xcd_barrier(const XcdBarrier& b) {
    asm volatile("s_waitcnt vmcnt(0)" ::: "memory");
    __syncthreads();
    if (threadIdx.x == 0) {
        unsigned* bar = b.bar;
        __builtin_amdgcn_s_waitcnt(0);
        unsigned nloc = b.st[0], nx = b.st[1];
        if (nloc == 0u) { xcd_barrier_complete(bar, b.x, nloc, nx); b.st[0] = nloc; b.st[1] = nx; }
        const unsigned old = xb_add(&bar[XB_XSUB(b.x)], 1u);
        const unsigned gen = old / nloc;
        if (old + 1u == (gen + 1u) * nloc) {
            __builtin_amdgcn_fence(__ATOMIC_RELEASE, "agent");
            asm volatile("s_waitcnt vmcnt(0)" ::: "memory");
            const unsigned og = xb_add(&bar[XB_TOP], 1u);
            const unsigned tg = og / nx;
            if (og + 1u == (tg + 1u) * nx) xb_add(&bar[XB_TOPGEN], 1u);
            else XB_SPIN(xb_ld(&bar[XB_TOPGEN]) == tg, bar);
            __builtin_amdgcn_fence(__ATOMIC_ACQUIRE, "agent");
            xb_add(&bar[XB_XGEN(b.x)], 1u);
            asm volatile("s_waitcnt vmcnt(0)" ::: "memory");
        } else {
            XB_SPIN(xb_ld(&bar[XB_XGEN(b.x)]) == gen, bar);
            __builtin_amdgcn_fence(__ATOMIC_ACQUIRE, "agent");
            asm volatile("s_waitcnt vmcnt(0)" ::: "memory");
        }
    }
    __syncthreads();
}

__global__ void __launch_bounds__(NWAVES * 64, 2) fwd_megakernel(Args args) {
    extern __shared__ __attribute__((aligned(16))) unsigned char lds_raw[];
    cg::grid_group grid = cg::this_grid();
    LAS unsigned char* lds = (LAS unsigned char*)lds_raw;
    const int tid = threadIdx.x, lane = tid & 63, wave = __builtin_amdgcn_readfirstlane(tid >> 6);
    unsigned char* ws = args.ws;
    const int G = gridDim.x, c = blockIdx.x;
    volatile LAS unsigned* xst = (volatile LAS unsigned*)(lds + LDS_BYTES - 16);
    if (tid < 4) xst[tid] = 0u;
    __syncthreads();

#ifndef NO_P0
    p0_prologue(args, lds, wave, lane);
#endif
    grid.sync();
    XcdBarrier xbar = xcd_barrier_post((unsigned*)(ws + WS_BAR), xst);
    {
        pg8::Gemm g{(const bf16_t*)(ws + WS_R1), (const bf16_t*)(ws + WS_WIN), M, DIN, DM}; pg8::StaticOrder S; S.init(M, DIN, G, c);
        pg8::EpiBf16<0> E{(bf16_t*)(ws + WS_Z), DIN, args.b_in, (float*)(ws + WS_PART)};
        pg8::gemm_phase<pg8::EpiBf16<0>, pg8::StaticOrder, true, true>(lds, g, S, E);
    }
    xcd_barrier(xbar);
#ifndef NO_MIX
    mixer_phase(args, lds, tid, wave, lane);
#endif
    xcd_barrier(xbar);
    {
        pg8::Gemm g{(const bf16_t*)(ws + WS_R2), (const bf16_t*)(ws + WS_WOUT), M, DM, DM}; pg8::StaticOrder S; S.init(M, DM, G, c);
        pg8::EpiBf16<2> E{(bf16_t*)(ws + WS_Y), DM, nullptr, nullptr};
        pg8::gemm_phase<pg8::EpiBf16<2>, pg8::StaticOrder, true, true>(lds, g, S, E);
    }
    xcd_barrier(xbar);
#ifndef NO_ROWS
    rows_mid(args, wave, lane);
#endif
    xcd_barrier(xbar);
    {
        pg8::Gemm g{(const bf16_t*)(ws + WS_R1), (const bf16_t*)(ws + WS_WFF1), M, DFF, DM}; pg8::StaticOrder S; S.init(M, DFF, G, c);
        pg8::EpiBf16<1> E{(bf16_t*)(ws + WS_Z), DFF, nullptr, nullptr};
        pg8::gemm_phase<pg8::EpiBf16<1>, pg8::StaticOrder, true, true>(lds, g, S, E);
    }
    xcd_barrier(xbar);
    {
        pg8::Gemm g{(const bf16_t*)(ws + WS_Z), (const bf16_t*)(ws + WS_WFF2), M, DM, DFF}; pg8::StaticOrder S; S.init(M, DM, G, c);
        pg8::EpiBf16<2> E{(bf16_t*)(ws + WS_R2), DM, nullptr, nullptr};
        pg8::gemm_phase<pg8::EpiBf16<2>, pg8::StaticOrder, true, true>(lds, g, S, E);
    }
    xcd_barrier(xbar);
#ifndef NO_ROWS
    rows_final(args, wave, lane);
#endif
}

extern "C" void kernel_launch(void* const* d_in, const int* in_sizes, int n_in, void* d_out, int out_size, void* d_ws, size_t ws_size, hipStream_t stream) {
    static int grid = 0;
    if (grid == 0) {
        if (n_in != 17 || in_sizes[0] != M * DM || out_size != M * DM || ws_size < WS_END) { fprintf(stderr, "kernel_launch: unexpected shapes (n_in %d in0 %d out %d ws %zu)\n", n_in, n_in > 0 ? in_sizes[0] : -1, out_size, ws_size); grid = -1; return; }
        int dev = 0, cus = 0, per_cu = 0;
        hipGetDevice(&dev);
        hipDeviceGetAttribute(&cus, hipDeviceAttributeMultiprocessorCount, dev);
        if (hipFuncSetAttribute((const void*)fwd_megakernel, hipFuncAttributeMaxDynamicSharedMemorySize, LDS_BYTES) != hipSuccess) { fprintf(stderr, "kernel_launch: hipFuncSetAttribute failed\n"); grid = -1; return; }
        if (hipOccupancyMaxActiveBlocksPerMultiprocessor(&per_cu, (const void*)fwd_megakernel, NWAVES * 64, LDS_BYTES) != hipSuccess || per_cu < 1) { fprintf(stderr, "kernel_launch: occupancy query says %d\n", per_cu); per_cu = 1; }
        (void)hipGetLastError();
        grid = cus * per_cu;
    }
    if (grid < 0) return;
    Args a{};
    a.x = (const float*)d_in[0]; a.n1pre = (const float*)d_in[1]; a.w_in = (const float*)d_in[2]; a.b_in = (const float*)d_in[3];
    a.w_pool = (const float*)d_in[4]; a.pool_scale = (const float*)d_in[5]; a.ln_g = (const float*)d_in[6]; a.ln_b = (const float*)d_in[7];
    a.w_sp = (const float*)d_in[8]; a.b_sp = (const float*)d_in[9]; a.w_sgu = (const float*)d_in[10]; a.w_out = (const float*)d_in[11];
    a.n1post = (const float*)d_in[12]; a.n2pre = (const float*)d_in[13]; a.w_ff1 = (const float*)d_in[14]; a.w_ff2 = (const float*)d_in[15]; a.n2post = (const float*)d_in[16];
    a.out = (float*)d_out; a.ws = (unsigned char*)d_ws;
    void* kargs[] = {&a};
    hipError_t e = hipLaunchCooperativeKernel((const void*)fwd_megakernel, dim3(grid), dim3(NWAVES * 64), kargs, LDS_BYTES, stream);
    if (e != hipSuccess) fprintf(stderr, "kernel_launch: cooperative launch failed: %s (grid %d)\n", hipGetErrorString(e), grid);
}
```
